# Optimizing an MI355X kernel written in HIP

```python
import jax
import jax.numpy as jnp
from jax import lax
import numpy as np

D_MODEL = 2048
BATCH = 4
SEQ = 2048
DEPTH = 2

GRID_W = 64
CTX_LEN = 256
NORM_EPS = 1e-6
ROPE_BASE = 10000.0
Q_BLOCK = 128

NA_HEADS = 8
NA_HEAD_DIM = 128
NA_WIDTH = NA_HEADS * NA_HEAD_DIM
NA_WIN_ROWS = 8
NA_WIN_COLS = 16

RW_HEAD_DIM = 64
RW_HEADS = 16
RW_WIDTH = RW_HEADS * RW_HEAD_DIM
RW_DECAY_RANK = 64
RW_ICLR_RANK = 64
RW_SHIFT_COLS = 3 * RW_WIDTH + 2 * RW_DECAY_RANK + 2 * RW_ICLR_RANK
RW_GN_EPS = 64e-5

MLA_HEADS = 8
MLA_Q_RANK = 512
MLA_KV_RANK = 512
MLA_NOPE_DIM = 128
MLA_ROPE_DIM = 64
MLA_V_DIM = 128
MLA_WIDTH = MLA_HEADS * MLA_V_DIM

HG_HEADS = 8
HG_EXPAND = 128
HG_HEAD_I = 128
HG_FDIM = HG_HEADS * HG_EXPAND
HG_WIDTH = HG_HEADS * HG_HEAD_I
HG_CHUNK = 32

EVEN_MIX = NA_WIDTH + RW_WIDTH
EVEN_IN = 3 * NA_WIDTH + RW_SHIFT_COLS + EVEN_MIX
ODD_MIX = MLA_WIDTH + HG_WIDTH
ODD_IN = MLA_Q_RANK + MLA_KV_RANK + MLA_ROPE_DIM + 3 * HG_FDIM + HG_WIDTH + ODD_MIX

kernel_name = 'hybrid_na_rwkv7_mla_hgrn2_dit'


def rms_norm(x, w):
    xf = x.astype(jnp.float32)
    y = xf * lax.rsqrt(jnp.mean(jnp.square(xf), axis=-1, keepdims=True) + NORM_EPS)
    return (y * w.astype(jnp.float32)).astype(x.dtype)


def adaln(cond, w, b):
    m = jax.nn.silu(cond) @ w + b
    return jnp.split(m, 3, axis=-1)


def heads(t, n):
    B, T, _ = t.shape
    return t.reshape(B, T, n, -1).transpose(0, 2, 1, 3)


def merge(t):
    B, n, T, d = t.shape
    return t.transpose(0, 2, 1, 3).reshape(B, T, n * d)


def softmax_f32(s, dtype):
    return jax.nn.softmax(s.astype(jnp.float32), axis=-1).astype(dtype)


def dense_attention(q, k, v):
    s = jnp.einsum('bhqd,bhkd->bhqk', q, k) * (q.shape[-1] ** -0.5)
    return jnp.einsum('bhqk,bhkd->bhqd', softmax_f32(s, v.dtype), v)


def axial_rope_angles(n_tokens, dim):
    t = jnp.arange(n_tokens, dtype=jnp.int32)
    pos = jnp.stack([t // GRID_W, t % GRID_W], axis=-1).astype(jnp.float32)
    n_freq = dim // 4
    inv = ROPE_BASE ** (-jnp.arange(n_freq, dtype=jnp.float32) / n_freq)
    return (pos[:, :, None] * inv).reshape(n_tokens, dim // 2)


def apply_rope(x, ang):
    xf = x.astype(jnp.float32).reshape(*x.shape[:-1], -1, 2)
    cos, sin = jnp.cos(ang), jnp.sin(ang)
    x0, x1 = xf[..., 0], xf[..., 1]
    y = jnp.stack([x0 * cos - x1 * sin, x0 * sin + x1 * cos], axis=-1)
    return y.reshape(x.shape).astype(x.dtype)


def neighbourhood_attention(q, k, v, kc, vc, rpb):
    B, H, T, d = q.shape
    rows = T // GRID_W
    kh, kw = min(NA_WIN_ROWS, rows), NA_WIN_COLS
    scale = d ** -0.5
    qg = q.reshape(B, H, rows, GRID_W, d)
    kg = k.reshape(B, H, rows, GRID_W, d)
    vg = v.reshape(B, H, rows, GRID_W, d)
    col = np.arange(GRID_W)
    col_start = np.clip(col - kw // 2, 0, GRID_W - kw)
    col_idx = col_start[:, None] + np.arange(kw)
    dx_idx = col_idx - col[:, None] + (NA_WIN_COLS - 1)
    rpb_cols = rpb[:, :, dx_idx]

    def one_row(r):
        r0 = jnp.clip(r - kh // 2, 0, rows - kh)
        q_r = lax.dynamic_index_in_dim(qg, r, axis=2, keepdims=False)
        k_w = lax.dynamic_slice_in_dim(kg, r0, kh, axis=2)[:, :, :, col_idx]
        v_w = lax.dynamic_slice_in_dim(vg, r0, kh, axis=2)[:, :, :, col_idx]
        dy_idx = r0 + jnp.arange(kh) - r + (NA_WIN_ROWS - 1)
        bias = jnp.take(rpb_cols, dy_idx, axis=1).transpose(0, 2, 1, 3)
        s_loc = jnp.einsum('bhjd,bhajkd->bhjak', q_r, k_w) * scale + bias[None]
        s_ctx = jnp.einsum('bhjd,bhld->bhjl', q_r, kc) * scale
        s = jnp.concatenate([s_loc.reshape(B, H, GRID_W, kh * kw), s_ctx], axis=-1)
        p = softmax_f32(s, v.dtype)
        p_loc = p[..., :kh * kw].reshape(B, H, GRID_W, kh, kw)
        return (jnp.einsum('bhjak,bhajkd->bhjd', p_loc, v_w)
                + jnp.einsum('bhjl,bhld->bhjd', p[..., kh * kw:], vc))

    out = lax.map(one_row, jnp.arange(rows))
    return out.transpose(1, 2, 0, 3, 4).reshape(B, H, T, d)


def token_shift(u, mu_prev, mu_next):
    prev = jnp.pad(u[:, :-1], ((0, 0), (1, 0), (0, 0)))
    nxt = jnp.pad(u[:, 1:], ((0, 0), (0, 1), (0, 0)))
    return u + mu_prev * (prev - u) + mu_next * (nxt - u)


def rwkv7_terms(u, w0, w2, a0, a2, k_k, k_a):
    B, T, _ = u.shape
    W, R = RW_WIDTH, RW_DECAY_RANK
    r, k, v, wd, ad = jnp.split(u.astype(jnp.float32), [W, 2 * W, 3 * W, 3 * W + 2 * R], axis=-1)
    wd = wd.reshape(B, T, 2, R)
    ad = ad.reshape(B, T, 2, RW_ICLR_RANK)
    w = w0 + jnp.einsum('btdr,drc->btdc', jnp.tanh(wd), w2)
    decay = jnp.exp(-jnp.exp(-jax.nn.softplus(-w) - 0.5))
    a = jax.nn.sigmoid(a0 + jnp.einsum('btdr,drc->btdc', ad, a2))
    kk = (k * k_k).reshape(B, T, RW_HEADS, RW_HEAD_DIM)
    kk = kk / jnp.maximum(jnp.linalg.norm(kk, axis=-1, keepdims=True), 1e-12)
    k_dir = k[:, :, None] * (1.0 + (a - 1.0) * k_a)

    def hd(t):
        return t.reshape(*t.shape[:-1], RW_HEADS, RW_HEAD_DIM)

    return hd(r), hd(decay), hd(k_dir), hd(v), kk, hd(a)


def dir_stack(t_fwd, t_bwd):
    return jnp.moveaxis(jnp.stack([t_fwd, jnp.flip(t_bwd, 1)], axis=0), 2, 0)


def dir_merge(y):
    y = jnp.moveaxis(y, 0, 2)
    return y[0] + jnp.flip(y[1], 1)


def rwkv7_scan(terms, s0):
    r, decay, k_dir, v, kk, a = terms
    xs = (dir_stack(r, r), dir_stack(decay[:, :, 0], decay[:, :, 1]),
          dir_stack(k_dir[:, :, 0], k_dir[:, :, 1]), dir_stack(v, v),
          dir_stack(-kk, -kk), dir_stack(kk * a[:, :, 0], kk * a[:, :, 1]))

    def step(S, inp):
        r_t, w_t, k_t, v_t, a_t, b_t = inp
        sa = jnp.einsum('...vk,...k->...v', S, a_t)
        S = S * w_t[..., None, :] + sa[..., :, None] * b_t[..., None, :] + v_t[..., :, None] * k_t[..., None, :]
        return S, jnp.einsum('...vk,...k->...v', S, r_t)

    s_fin, y = lax.scan(step, s0, xs)
    return dir_merge(y), s_fin


def rwkv7_readout(y, terms, r_k, ln_w, ln_b, dtype):
    r, _, k_dir, v, _, _ = terms
    B, T = y.shape[:2]
    mu = jnp.mean(y, axis=-1, keepdims=True)
    var = jnp.mean(jnp.square(y - mu), axis=-1, keepdims=True)
    yn = ((y - mu) * lax.rsqrt(var + RW_GN_EPS)).reshape(B, T, RW_WIDTH) * ln_w + ln_b
    bonus = jnp.sum(r[:, :, None] * k_dir * r_k, axis=(2, 4))[..., None] * v
    return (yn + bonus.reshape(B, T, RW_WIDTH)).astype(dtype)


def rwkv7_mixer(u, uc, w0, w2, a0, a2, k_k, k_a, r_k, ln_w, ln_b, ctx_out):
    terms = rwkv7_terms(u, w0, w2, a0, a2, k_k, k_a)
    terms_c = rwkv7_terms(uc, w0, w2, a0, a2, k_k, k_a)
    s0 = jnp.zeros((2, u.shape[0], RW_HEADS, RW_HEAD_DIM, RW_HEAD_DIM), jnp.float32)
    yc, s_ctx = rwkv7_scan(terms_c, s0)
    y, _ = rwkv7_scan(terms, s_ctx)
    out = rwkv7_readout(y, terms, r_k, ln_w, ln_b, u.dtype)
    if not ctx_out:
        return out, None
    return out, rwkv7_readout(yc, terms_c, r_k, ln_w, ln_b, u.dtype)


def mla_queries(cq, q_norm, w_uq):
    q = heads(rms_norm(cq, q_norm) @ w_uq, MLA_HEADS)
    return q[..., :MLA_NOPE_DIM], q[..., MLA_NOPE_DIM:]


def mla_keys(ckv, kpe, kv_norm, w_ukv):
    kv = heads(rms_norm(ckv, kv_norm) @ w_ukv, MLA_HEADS)
    return kv[..., :MLA_NOPE_DIM], kpe, kv[..., MLA_NOPE_DIM:]


def mla_attention(q_nope, q_pe, k_nope, k_pe, v):
    B, H, T, _ = q_nope.shape
    nb = T // Q_BLOCK
    scale = (MLA_NOPE_DIM + MLA_ROPE_DIM) ** -0.5
    qn = jnp.moveaxis(q_nope.reshape(B, H, nb, Q_BLOCK, -1), 2, 0)
    qp = jnp.moveaxis(q_pe.reshape(B, H, nb, Q_BLOCK, -1), 2, 0)

    def block(args):
        qn_b, qp_b = args
        s = (jnp.einsum('bhqd,bhkd->bhqk', qn_b, k_nope) + jnp.einsum('bhqd,bkd->bhqk', qp_b, k_pe)) * scale
        return jnp.einsum('bhqk,bhkd->bhqd', softmax_f32(s, v.dtype), v)

    out = lax.map(block, (qn, qp))
    return jnp.moveaxis(out, 0, 2).reshape(B, H, T, -1)


def hgrn2_chunk_scan(q, log_f, k, v, s0):
    *lead, T, _ = q.shape
    dv = v.shape[-1]
    n = T // HG_CHUNK

    def chunks(t):
        return t.reshape(*lead, n, HG_CHUNK, t.shape[-1])

    qc, gc, kc, vc = chunks(q), chunks(log_f), chunks(k), chunks(v)
    b = jnp.cumsum(gc, axis=-2)
    b_last = b[..., -1:, :]
    q_in = qc * jnp.exp(b)
    k_in = kc * jnp.exp(-b)
    k_end = kc * jnp.exp(b_last - b)
    mask = jnp.tril(jnp.ones((HG_CHUNK, HG_CHUNK), jnp.float32))
    attn = jnp.einsum('...id,...jd->...ij', q_in, k_in) * mask
    o_intra = jnp.einsum('...ij,...je->...ie', attn, vc)
    ds = jnp.einsum('...cd,...ce->...de', k_end, vc)
    dec = jnp.exp(b_last[..., 0, :])

    def step(S, inp):
        d_c, ds_c = inp
        return d_c[..., :, None] * S + ds_c, S

    s_fin, s_prev = lax.scan(step, s0, (jnp.moveaxis(dec, -2, 0), jnp.moveaxis(ds, -3, 0)))
    s_prev = jnp.moveaxis(s_prev, 0, -3)
    o = o_intra + jnp.einsum('...cd,...de->...ce', q_in, s_prev)
    return o.reshape(*lead, T, dv), s_fin


def hgrn2_terms(zz, lb):
    F = HG_FDIM
    B, T, _ = zz.shape
    q, f_fw, f_bw, i = jnp.split(zz, [F, 2 * F, 3 * F], axis=-1)
    fz = jnp.stack([f_fw, f_bw], axis=0).astype(jnp.float32)
    log_f = jnp.logaddexp(jnp.log(lb), jnp.log1p(-lb) + jax.nn.log_sigmoid(fz))
    k = (1.0 - lb) * jax.nn.sigmoid(-fz)

    def dir_heads(t):
        t = t.reshape(2, B, T, HG_HEADS, -1).transpose(0, 1, 3, 2, 4)
        return jnp.stack([t[0], jnp.flip(t[1], 2)], axis=0)

    def shared(t):
        t = heads(t, HG_HEADS).astype(jnp.float32)
        return jnp.stack([t, jnp.flip(t, 2)], axis=0)

    return shared(q), dir_heads(log_f), dir_heads(k), shared(i)


def hgrn2_mixer(zz, zzc, lb, norm_w, ctx_out):
    s0 = jnp.zeros((2, zz.shape[0], HG_HEADS, HG_EXPAND, HG_HEAD_I), jnp.float32)
    oc, s_ctx = hgrn2_chunk_scan(*hgrn2_terms(zzc, lb), s0)
    ol, _ = hgrn2_chunk_scan(*hgrn2_terms(zz, lb), s_ctx)

    def readout(o):
        o = o[0] + jnp.flip(o[1], 2)
        return merge(rms_norm(o, norm_w)).astype(zz.dtype)

    if not ctx_out:
        return readout(ol), None
    return readout(ol), readout(oc)


def even_mixers(z, zc, rpb, mu, w0, w2, a0, a2, k_k, k_a, r_k, ln_w, ln_b, ctx_out):
    s1 = 3 * NA_WIDTH
    s2 = s1 + RW_SHIFT_COLS
    q, k, v = (heads(t, NA_HEADS) for t in jnp.split(z[..., :s1], 3, axis=-1))
    qc_raw, kc_raw, vc_raw = jnp.split(zc[..., :s1], 3, axis=-1)
    kc, vc = heads(kc_raw, NA_HEADS), heads(vc_raw, NA_HEADS)
    y_na = merge(neighbourhood_attention(q, k, v, kc, vc, rpb))
    u = token_shift(z[..., s1:s2], mu[0], mu[1])
    uc = token_shift(zc[..., s1:s2], mu[0], mu[1])
    y_rw, yc_rw = rwkv7_mixer(u, uc, w0, w2, a0, a2, k_k, k_a, r_k, ln_w, ln_b, ctx_out)
    y = jnp.concatenate([y_na, y_rw], axis=-1) * jax.nn.silu(z[..., s2:])
    if not ctx_out:
        return y, None
    yc_na = merge(dense_attention(heads(qc_raw, NA_HEADS), kc, vc))
    yc = jnp.concatenate([yc_na, yc_rw], axis=-1) * jax.nn.silu(zc[..., s2:])
    return y, yc


def odd_mixers(z, zc, q_norm, w_uq, kv_norm, w_ukv, lb, hg_norm_w, ctx_out):
    o1 = MLA_Q_RANK
    o2 = o1 + MLA_KV_RANK
    o3 = o2 + MLA_ROPE_DIM
    o4 = o3 + 3 * HG_FDIM + HG_WIDTH
    ang = axial_rope_angles(z.shape[1], MLA_ROPE_DIM)
    qn, qp = mla_queries(z[..., :o1], q_norm, w_uq)
    kn, kp, v = mla_keys(z[..., o1:o2], z[..., o2:o3], kv_norm, w_ukv)
    knc, kpc, vc = mla_keys(zc[..., o1:o2], zc[..., o2:o3], kv_norm, w_ukv)
    qp = apply_rope(qp, ang)
    kp = apply_rope(kp, ang)
    y_mla = merge(mla_attention(qn, qp, jnp.concatenate([kn, knc], axis=2),
                                jnp.concatenate([kp, kpc], axis=1), jnp.concatenate([v, vc], axis=2)))
    y_hg, yc_hg = hgrn2_mixer(z[..., o3:o4], zc[..., o3:o4], lb, hg_norm_w, ctx_out)
    y = jnp.concatenate([y_mla, y_hg], axis=-1) * jax.nn.silu(z[..., o4:])
    if not ctx_out:
        return y, None
    qnc, qpc = mla_queries(zc[..., :o1], q_norm, w_uq)
    yc_mla = merge(mla_attention(qnc, qpc, knc, kpc, vc))
    yc = jnp.concatenate([yc_mla, yc_hg], axis=-1) * jax.nn.silu(zc[..., o4:])
    return y, yc


def setup_inputs(seed: int = 0) -> dict:
    key = jax.random.key(seed)
    ks = iter(jax.random.split(key, 40))
    f32 = jnp.float32
    D = D_MODEL
    ne = (DEPTH + 1) // 2
    no = DEPTH // 2

    def nrm(shape, scale):
        return jax.random.normal(next(ks), shape, f32) * scale

    def unif(shape, lo, hi):
        return jax.random.uniform(next(ks), shape, f32, lo, hi)

    return {
        'x': nrm((BATCH, SEQ, D), 1.0),
        'c': nrm((BATCH, D), 1.0),
        'ctx': nrm((BATCH, CTX_LEN, D), 1.0),
        'c_ctx': nrm((D,), 1.0),
        'ada_w': nrm((DEPTH, D, 3 * D), 0.5 * D ** -0.5),
        'ada_b': nrm((DEPTH, 3 * D), 0.02),
        'norm_w': 1.0 + nrm((DEPTH, D), 0.02),
        'e_w_in': nrm((ne, D, EVEN_IN), D ** -0.5),
        'e_w_out': nrm((ne, EVEN_MIX, D), EVEN_MIX ** -0.5),
        'na_rpb': nrm((ne, NA_HEADS, 2 * NA_WIN_ROWS - 1, 2 * NA_WIN_COLS - 1), 0.2),
        'rw_mu': unif((ne, 2, RW_SHIFT_COLS), 0.0, 0.5),
        'rw_w0': unif((ne, 2, RW_WIDTH), -6.0, 1.0),
        'rw_w2': nrm((ne, 2, RW_DECAY_RANK, RW_WIDTH), 0.1),
        'rw_a0': nrm((ne, 2, RW_WIDTH), 0.5),
        'rw_a2': nrm((ne, 2, RW_ICLR_RANK, RW_WIDTH), 0.1),
        'rw_k_k': 0.85 + nrm((ne, RW_WIDTH), 0.05),
        'rw_k_a': 1.0 + nrm((ne, RW_WIDTH), 0.05),
        'rw_r_k': nrm((ne, RW_HEADS, RW_HEAD_DIM), 0.1),
        'rw_ln_w': 1.0 + nrm((ne, RW_WIDTH), 0.02),
        'rw_ln_b': nrm((ne, RW_WIDTH), 0.02),
        'o_w_in': nrm((no, D, ODD_IN), D ** -0.5),
        'o_w_out': nrm((no, ODD_MIX, D), ODD_MIX ** -0.5),
        'mla_q_norm': 1.0 + nrm((no, MLA_Q_RANK), 0.02),
        'mla_w_uq': nrm((no, MLA_Q_RANK, MLA_HEADS * (MLA_NOPE_DIM + MLA_ROPE_DIM)), MLA_Q_RANK ** -0.5),
        'mla_kv_norm': 1.0 + nrm((no, MLA_KV_RANK), 0.02),
        'mla_w_ukv': nrm((no, MLA_KV_RANK, MLA_HEADS * (MLA_NOPE_DIM + MLA_V_DIM)), MLA_KV_RANK ** -0.5),
        'hg_lower_bounds': 1.0 + nrm((DEPTH, HG_FDIM), 0.1),
        'hg_norm_w': 1.0 + nrm((no, HG_HEAD_I), 0.02),
        'final_norm_w': 1.0 + nrm((D,), 0.02),
    }


def reference(x, c, ctx, c_ctx, ada_w, ada_b, norm_w, e_w_in, e_w_out, na_rpb, rw_mu, rw_w0, rw_w2,
              rw_a0, rw_a2, rw_k_k, rw_k_a, rw_r_k, rw_ln_w, rw_ln_b, o_w_in, o_w_out, mla_q_norm,
              mla_w_uq, mla_kv_norm, mla_w_ukv, hg_lower_bounds, hg_norm_w, final_norm_w):
    s = jax.nn.softmax(hg_lower_bounds.astype(jnp.float32), axis=0)
    lower_bounds = jnp.cumsum(s, axis=0) - s[0]
    xc = ctx
    for l in range(DEPTH):
        ctx_out = l < DEPTH - 1
        i = l // 2
        shift, scale, gate = adaln(c[:, None, :], ada_w[l], ada_b[l])
        shift_c, scale_c, gate_c = adaln(c_ctx, ada_w[l], ada_b[l])
        h = rms_norm(x, norm_w[l]) * (1.0 + scale) + shift
        hc = rms_norm(xc, norm_w[l]) * (1.0 + scale_c) + shift_c
        if l % 2 == 0:
            y, yc = even_mixers(h @ e_w_in[i], hc @ e_w_in[i], na_rpb[i], rw_mu[i], rw_w0[i], rw_w2[i],
                                rw_a0[i], rw_a2[i], rw_k_k[i], rw_k_a[i], rw_r_k[i], rw_ln_w[i],
                                rw_ln_b[i], ctx_out)
            w_out = e_w_out[i]
        else:
            y, yc = odd_mixers(h @ o_w_in[i], hc @ o_w_in[i], mla_q_norm[i], mla_w_uq[i], mla_kv_norm[i],
                               mla_w_ukv[i], lower_bounds[l], hg_norm_w[i], ctx_out)
            w_out = o_w_out[i]
        x = x + gate * (y @ w_out)
        if ctx_out:
            xc = xc + gate_c * (yc @ w_out)
    return rms_norm(x, final_norm_w)
```

```cpp
#ifndef HOST_TEST
#include <hip/hip_runtime.h>
#include <hip/hip_cooperative_groups.h>
#include <cstdio>
#include <cstring>
namespace cg = cooperative_groups;
#define HD __host__ __device__ __forceinline__
#else
#include <cmath>
#include <cstdio>
#include <cstdlib>
#include <cstring>
#define HD inline
#endif

#ifndef FUSED
#define FUSED 0
#endif

typedef unsigned short bf16;

#ifdef HOST_TEST
constexpr int D = HT_D, BATCH = HT_B, SEQ = HT_SEQ, CTX = HT_CTX;
#else
constexpr int D = 2048, BATCH = 4, SEQ = 2048, CTX = 256;
#endif
constexpr int ML = BATCH * SEQ;
constexpr int MC = BATCH * CTX;
constexpr int M = ML + MC;
constexpr int GW = 64, ROWS = SEQ / GW;
constexpr int D3 = 3 * D;
constexpr int EVEN_IN = 8448, ODD_IN = 7232;
constexpr int NMOD = BATCH + 1;
constexpr float NORM_EPS = 1e-6f;

struct Params {
  const float *x, *c, *ctx, *c_ctx, *ada_w, *ada_b, *norm_w, *e_w_in, *e_w_out, *na_rpb, *rw_mu, *rw_w0, *rw_w2, *rw_a0, *rw_a2,
      *rw_k_k, *rw_k_a, *rw_r_k, *rw_ln_w, *rw_ln_b, *o_w_in, *o_w_out, *mla_q_norm, *mla_w_uq, *mla_kv_norm, *mla_w_ukv, *hg_lb,
      *hg_norm_w, *final_norm_w;
  float* out;
  float* mod;
  bf16* H;
  bf16* YALL;
  float* XC1;
  bf16* QKV0;
  bf16* G0;
  bf16* U0;
  float* Y;
  float* LR;
  float* KN;
  bf16 *R, *V, *KK;
  bf16 *KD, *BB, *E;
  bf16* CQKV;
  bf16 *HGQ, *HGI;
  bf16* HGF;
  bf16* G1;
  bf16 *CQN;
  bf16 *CKVN;
  bf16* KPE;
  bf16* Q;
  bf16* KV;
  float* O1;
};

HD float bf2f(bf16 v) {
  union { unsigned u; float f; } x;
  x.u = ((unsigned)v) << 16;
  return x.f;
}
HD bf16 f2bf(float f) {
  union { unsigned u; float f; } x;
  x.f = f;
  unsigned r = x.u + 0x7FFFu + ((x.u >> 16) & 1u);
  return (bf16)(r >> 16);
}
HD float sigmoidf_(float x) { return 1.0f / (1.0f + expf(-x)); }
HD float siluf_(float x) { return x / (1.0f + expf(-x)); }
HD int clampi(int v, int lo, int hi) { return v < lo ? lo : (v > hi ? hi : v); }

#if defined(__HIP_DEVICE_COMPILE__)
#define UNIFORM(x) __builtin_amdgcn_readfirstlane(x)
#else
#define UNIFORM(x) (x)
#endif

HD void atomic_addf(float* p, float v) {
#if defined(__HIP_DEVICE_COMPILE__)
  atomicAdd(p, v);
#elif defined(HOST_TEST)
#pragma omp atomic
  *p += v;
#else
  *p += v;
#endif
}

constexpr long N_ADALN = 2L * D3;
HD void body_adaln(const Params& p, long gid) {
  int l = (int)(gid / D3), j = (int)(gid % D3);
  float acc[NMOD];
#pragma unroll
  for (int r = 0; r < NMOD; r++) acc[r] = 0.f;
  const float* w = p.ada_w + (long)l * D * D3 + j;
  for (int k = 0; k < D; k++) {
    float wv = w[(long)k * D3];
#pragma unroll
    for (int r = 0; r < NMOD; r++) {
      float cv = (r < BATCH) ? p.c[r * D + k] : p.c_ctx[k];
      acc[r] += siluf_(cv) * wv;
    }
  }
#pragma unroll
  for (int r = 0; r < NMOD; r++) p.mod[((long)l * NMOD + r) * D3 + j] = acc[r] + p.ada_b[l * D3 + j];
}

HD void body_normmod(const Params& p, int l, long m) {
  const float* src;
  int r;
  if (m < ML) {
    src = (l == 0 ? p.x : p.out) + m * D;
    r = (int)(m / SEQ);
  } else {
    src = (l == 0 ? p.ctx : p.XC1) + (m - ML) * D;
    r = BATCH;
  }
  float ss = 0.f;
  for (int k = 0; k < D; k++) ss += src[k] * src[k];
  float rstd = 1.0f / sqrtf(ss / D + NORM_EPS);
  const float* md = p.mod + ((long)l * NMOD + r) * D3;
  const float* nw = p.norm_w + l * D;
  for (int k = 0; k < D; k++) p.H[m * D + k] = f2bf(src[k] * rstd * nw[k] * (1.0f + md[D + k]) + md[k]);
}

struct EpiIn0 {
  const Params p_;
  HD void operator()(int m, int n, float v) const {
    if (n < 3072) p_.QKV0[(long)m * 3072 + n] = f2bf(v);
    else if (n < 6400) p_.U0[(long)m * 3328 + (n - 3072)] = f2bf(v);
    else p_.G0[(long)m * 2048 + (n - 6400)] = f2bf(siluf_(v));
  }
};
struct EpiOut0 {
  const Params p_;
  HD void operator()(int m, int n, float v) const {
    if (m < ML) {
      int b = m / SEQ;
      p_.out[(long)m * D + n] = p_.x[(long)m * D + n] + p_.mod[((long)0 * NMOD + b) * D3 + 2 * D + n] * v;
    } else {
      p_.XC1[(long)(m - ML) * D + n] = p_.ctx[(long)(m - ML) * D + n] + p_.mod[((long)0 * NMOD + BATCH) * D3 + 2 * D + n] * v;
    }
  }
};
struct EpiIn1 {
  const Params p_;
  HD void operator()(int m, int n, float v) const {
    if (n < 1088) p_.CQKV[(long)m * 1088 + n] = f2bf(v);
    else if (n < 2112) p_.HGQ[(long)m * 1024 + (n - 1088)] = f2bf(v);
    else if (n < 3136) p_.HGF[(long)m * 1024 + (n - 2112)] = f2bf(v);
    else if (n < 4160) p_.HGF[((long)M + m) * 1024 + (n - 3136)] = f2bf(v);
    else if (n < 5184) p_.HGI[(long)m * 1024 + (n - 4160)] = f2bf(v);
    else if (m < ML) p_.G1[(long)m * 2048 + (n - 5184)] = f2bf(siluf_(v));
  }
};
struct EpiQ {
  const Params p_;
  HD void operator()(int m, int n, float v) const { p_.Q[(long)m * 1536 + n] = f2bf(v); }
};
struct EpiKV {
  const Params p_;
  HD void operator()(int m, int n, float v) const { p_.KV[(long)m * 2048 + n] = f2bf(v); }
};
struct EpiOut1 {
  const Params p_;
  HD void operator()(int m, int n, float v) const {
    int b = m / SEQ;
    p_.out[(long)m * D + n] += p_.mod[((long)1 * NMOD + b) * D3 + 2 * D + n] * v;
  }
};

HD float ushift(const Params& p, long m, int c) {
  bool first, last;
  if (m < ML) {
    int t = (int)(m % SEQ);
    first = (t == 0);
    last = (t == SEQ - 1);
  } else {
    int t = (int)((m - ML) % CTX);
    first = (t == 0);
    last = (t == CTX - 1);
  }
  float u = bf2f(p.U0[m * 3328 + c]);
  float pv = first ? 0.f : bf2f(p.U0[(m - 1) * 3328 + c]);
  float nx = last ? 0.f : bf2f(p.U0[(m + 1) * 3328 + c]);
  return u + p.rw_mu[c] * (pv - u) + p.rw_mu[3328 + c] * (nx - u);
}

constexpr long N_LR = (long)M * 256;
HD void body_rwkv_lr(const Params& p, long gid) {
  long m = gid / 256;
  int j = (int)(gid % 256);
  float v = ushift(p, m, 3072 + j);
  p.LR[gid] = (j < 128) ? tanhf(v) : v;
}
constexpr long N_KN = (long)M * 16;
HD void body_rwkv_kn(const Params& p, long gid) {
  long m = gid / 16;
  int h = (int)(gid % 16);
  float ss = 0.f;
  for (int i = 0; i < 64; i++) {
    int c = h * 64 + i;
    float k = ushift(p, m, 1024 + c) * p.rw_k_k[c];
    ss += k * k;
  }
  p.KN[gid] = 1.0f / fmaxf(sqrtf(ss), 1e-12f);
}
constexpr long N_TERMS = (long)M * 1024;
HD void body_rwkv_terms(const Params& p, long gid) {
  long m = gid / 1024;
  int c = (int)(gid % 1024);
  float r = ushift(p, m, c), k = ushift(p, m, 1024 + c), v = ushift(p, m, 2048 + c);
  float kk = k * p.rw_k_k[c] * p.KN[m * 16 + (c >> 6)];
  p.R[gid] = f2bf(r);
  p.V[gid] = f2bf(v);
  p.KK[gid] = f2bf(kk);
  const float* lr = p.LR + m * 256;
#pragma unroll
  for (int d = 0; d < 2; d++) {
    float w = p.rw_w0[d * 1024 + c], a = p.rw_a0[d * 1024 + c];
    const float* w2 = p.rw_w2 + (long)d * 64 * 1024 + c;
    const float* a2 = p.rw_a2 + (long)d * 64 * 1024 + c;
    for (int j = 0; j < 64; j++) {
      w += lr[d * 64 + j] * w2[j * 1024];
      a += lr[128 + d * 64 + j] * a2[j * 1024];
    }
    float e = sigmoidf_(w) * 0.60653065971263342f;
    a = sigmoidf_(a);
    float kd = k * (1.0f + (a - 1.0f) * p.rw_k_a[c]);
    long o = (long)d * M * 1024 + gid;
    p.E[o] = f2bf(e);
    p.KD[o] = f2bf(kd);
    p.BB[o] = f2bf(kk * a);
  }
}

constexpr long N_NA = 4L * 8 * M;
HD void body_na(const Params& p, long gid) {
  long m = gid % M;
  int h = (int)((gid / M) % 8);
  int dc = (int)(gid / ((long)M * 8));
  const bf16* q = p.QKV0 + m * 3072 + h * 128;
  const float scale = 0.08838834764831845f;
  float o[32];
#pragma unroll
  for (int i = 0; i < 32; i++) o[i] = 0.f;
  float mx = -1e30f, l = 0.f;
  int b;
  int nloc = 0, r = 0, j = 0, r0 = 0, c0 = 0;
  if (m < ML) {
    b = (int)(m / SEQ);
    int t = (int)(m % SEQ);
    r = t / GW;
    j = t % GW;
    r0 = clampi(r - 4, 0, ROWS - 8);
    c0 = clampi(j - 8, 0, GW - 16);
    nloc = 128;
  } else {
    b = (int)((m - ML) / CTX);
  }
  for (int kidx = 0; kidx < nloc + CTX; kidx++) {
    long mk;
    float bias = 0.f;
    if (kidx < nloc) {
      int a = kidx >> 4, kx = kidx & 15;
      mk = (long)b * SEQ + (r0 + a) * GW + c0 + kx;
      bias = p.na_rpb[(h * 15 + (r0 + a - r + 7)) * 31 + (c0 + kx - j + 15)];
    } else {
      mk = ML + (long)b * CTX + (kidx - nloc);
    }
    const bf16* kp = p.QKV0 + mk * 3072 + 1024 + h * 128;
    float s = 0.f;
    for (int d = 0; d < 128; d++) s += bf2f(q[d]) * bf2f(kp[d]);
    s = s * scale + bias;
    if (s > mx) {
      float f = expf(mx - s);
      l *= f;
#pragma unroll
      for (int i = 0; i < 32; i++) o[i] *= f;
      mx = s;
    }
    float pe = expf(s - mx);
    l += pe;
    const bf16* vp = p.QKV0 + mk * 3072 + 2048 + h * 128 + dc * 32;
#pragma unroll
    for (int i = 0; i < 32; i++) o[i] += pe * bf2f(vp[i]);
  }
  float inv = 1.0f / l;
  int col = h * 128 + dc * 32;
#pragma unroll
  for (int i = 0; i < 32; i++) p.YALL[m * 2048 + col + i] = f2bf(o[i] * inv * bf2f(p.G0[m * 2048 + col + i]));
}

constexpr long N_RWSCAN = 2L * BATCH * 16 * 64;
HD void body_rwkv_scan(const Params& p, long gid) {
  int v = (int)(gid % 64);
  int h = UNIFORM((int)((gid / 64) % 16));
  int b = UNIFORM((int)((gid / 1024) % BATCH));
  int d = UNIFORM((int)(gid / (1024L * BATCH)));
  float S[64];
#pragma unroll
  for (int i = 0; i < 64; i++) S[i] = 0.f;
  for (int ph = 0; ph < 2; ph++) {
    int Tn = ph == 0 ? CTX : SEQ;
    long base = ph == 0 ? (ML + (long)b * CTX) : ((long)b * SEQ);
    for (int s = 0; s < Tn; s++) {
      int t = d == 0 ? s : Tn - 1 - s;
      long m = base + t;
      long o1 = m * 1024 + h * 64;
      long o2 = (long)d * M * 1024 + o1;
      float vv = bf2f(p.V[o1 + v]);
      float sa = 0.f;
#pragma unroll
      for (int i = 0; i < 64; i++) sa -= S[i] * bf2f(p.KK[o1 + i]);
      float y = 0.f;
#pragma unroll
      for (int i = 0; i < 64; i++) {
        float w = expf(-bf2f(p.E[o2 + i]));
        float sn = S[i] * w + sa * bf2f(p.BB[o2 + i]) + vv * bf2f(p.KD[o2 + i]);
        S[i] = sn;
        y += sn * bf2f(p.R[o1 + i]);
      }
      atomic_addf(&p.Y[o1 + v], y);
    }
  }
}

constexpr long N_RWOUT = (long)M * 16;
HD void body_rwkv_out(const Params& p, long gid) {
  long m = gid / 16;
  int h = (int)(gid % 16);
  long o1 = m * 1024 + h * 64;
  float mu = 0.f;
  for (int i = 0; i < 64; i++) mu += p.Y[o1 + i];
  mu *= (1.0f / 64);
  float var = 0.f, bonus = 0.f;
  for (int i = 0; i < 64; i++) {
    float dlt = p.Y[o1 + i] - mu;
    var += dlt * dlt;
    float kd = bf2f(p.KD[o1 + i]) + bf2f(p.KD[(long)M * 1024 + o1 + i]);
    bonus += bf2f(p.R[o1 + i]) * kd * p.rw_r_k[h * 64 + i];
  }
  float rs = 1.0f / sqrtf(var * (1.0f / 64) + 64e-5f);
  for (int i = 0; i < 64; i++) {
    int c = h * 64 + i;
    float yn = (p.Y[o1 + i] - mu) * rs * p.rw_ln_w[c] + p.rw_ln_b[c] + bonus * bf2f(p.V[o1 + i]);
    p.YALL[m * 2048 + 1024 + c] = f2bf(yn * bf2f(p.G0[m * 2048 + 1024 + c]));
  }
}

HD void rope_angle(int t, int i, float& cs, float& sn) {
  int f = i & 15;
  float pos = (float)((i < 16) ? (t / GW) : (t % GW));
  float inv = powf(10000.0f, -(float)f / 16.0f);
  float ang = pos * inv;
  cs = cosf(ang);
  sn = sinf(ang);
}
HD void body_mla_prep(const Params& p, long m) {
  const bf16* z = p.CQKV + m * 1088;
  if (m < ML) {
    float ss = 0.f;
    for (int k = 0; k < 512; k++) ss += bf2f(z[k]) * bf2f(z[k]);
    float rstd = 1.0f / sqrtf(ss / 512 + NORM_EPS);
    for (int k = 0; k < 512; k++) p.CQN[m * 512 + k] = f2bf(bf2f(z[k]) * rstd * p.mla_q_norm[k]);
  }
  {
    float ss = 0.f;
    for (int k = 0; k < 512; k++) ss += bf2f(z[512 + k]) * bf2f(z[512 + k]);
    float rstd = 1.0f / sqrtf(ss / 512 + NORM_EPS);
    for (int k = 0; k < 512; k++) p.CKVN[m * 512 + k] = f2bf(bf2f(z[512 + k]) * rstd * p.mla_kv_norm[k]);
  }
  for (int i = 0; i < 32; i++) {
    float x0 = bf2f(z[1024 + 2 * i]), x1 = bf2f(z[1024 + 2 * i + 1]);
    if (m < ML) {
      float cs, sn;
      rope_angle((int)(m % SEQ), i, cs, sn);
      float y0 = x0 * cs - x1 * sn, y1 = x0 * sn + x1 * cs;
      x0 = y0;
      x1 = y1;
    }
    p.KPE[m * 64 + 2 * i] = f2bf(x0);
    p.KPE[m * 64 + 2 * i + 1] = f2bf(x1);
  }
}
constexpr long N_ROPEQ = (long)ML * 8 * 32;
HD void body_rope_q(const Params& p, long gid) {
  int i = (int)(gid % 32);
  int h = (int)((gid / 32) % 8);
  long m = gid / 256;
  bf16* q = p.Q + m * 1536 + h * 192 + 128 + 2 * i;
  float cs, sn;
  rope_angle((int)(m % SEQ), i, cs, sn);
  float x0 = bf2f(q[0]), x1 = bf2f(q[1]);
  q[0] = f2bf(x0 * cs - x1 * sn);
  q[1] = f2bf(x0 * sn + x1 * cs);
}

constexpr long N_MLA = 4L * BATCH * 8 * SEQ;
HD void body_mla(const Params& p, long gid) {
  int t = (int)(gid % SEQ);
  int h = UNIFORM((int)((gid / SEQ) % 8));
  int b = UNIFORM((int)((gid / (8L * SEQ)) % BATCH));
  int dc = UNIFORM((int)(gid / (8L * SEQ * BATCH)));
  long m = (long)b * SEQ + t;
  const bf16* q = p.Q + m * 1536 + h * 192;
  const float scale = 0.07216878364870322f;
  float o[32];
#pragma unroll
  for (int i = 0; i < 32; i++) o[i] = 0.f;
  float mx = -1e30f, l = 0.f;
  for (int kidx = 0; kidx < SEQ + CTX; kidx++) {
    long mk = kidx < SEQ ? ((long)b * SEQ + kidx) : (ML + (long)b * CTX + (kidx - SEQ));
    const bf16* kn = p.KV + mk * 2048 + h * 256;
    const bf16* kp = p.KPE + mk * 64;
    float s = 0.f;
    for (int d = 0; d < 128; d++) s += bf2f(q[d]) * bf2f(kn[d]);
    for (int d = 0; d < 64; d++) s += bf2f(q[128 + d]) * bf2f(kp[d]);
    s *= scale;
    if (s > mx) {
      float f = expf(mx - s);
      l *= f;
#pragma unroll
      for (int i = 0; i < 32; i++) o[i] *= f;
      mx = s;
    }
    float pe = expf(s - mx);
    l += pe;
    const bf16* vp = kn + 128 + dc * 32;
#pragma unroll
    for (int i = 0; i < 32; i++) o[i] += pe * bf2f(vp[i]);
  }
  float inv = 1.0f / l;
  int col = h * 128 + dc * 32;
#pragma unroll
  for (int i = 0; i < 32; i++) p.YALL[m * 2048 + col + i] = f2bf(o[i] * inv * bf2f(p.G1[m * 2048 + col + i]));
}

constexpr long N_HGSCAN = 2L * BATCH * 8 * 128;
HD void body_hg_scan(const Params& p, long gid) {
  int e = (int)(gid % 128);
  int h = UNIFORM((int)((gid / 128) % 8));
  int b = UNIFORM((int)((gid / 1024) % BATCH));
  int d = UNIFORM((int)(gid / (1024L * BATCH)));
  float S[128];
#pragma unroll
  for (int i = 0; i < 128; i++) S[i] = 0.f;
  for (int ph = 0; ph < 2; ph++) {
    int Tn = ph == 0 ? CTX : SEQ;
    long base = ph == 0 ? (ML + (long)b * CTX) : ((long)b * SEQ);
    for (int s = 0; s < Tn; s++) {
      int t = d == 0 ? s : Tn - 1 - s;
      long m = base + t;
      long o1 = m * 1024 + h * 128;
      const bf16* fp = p.HGF + (long)d * M * 1024 + o1;
      float vv = bf2f(p.HGI[o1 + e]);
      float o = 0.f;
#pragma unroll
      for (int i = 0; i < 128; i++) {
        float h0 = p.hg_lb[h * 128 + i], h1 = p.hg_lb[1024 + h * 128 + i];
        float lb = 1.0f / (1.0f + expf(h0 - h1));
        float sg = sigmoidf_(bf2f(fp[i]));
        float f = lb + (1.0f - lb) * sg;
        float kk = (1.0f - lb) * (1.0f - sg);
        float sn = f * S[i] + kk * vv;
        S[i] = sn;
        o += bf2f(p.HGQ[o1 + i]) * sn;
      }
      if (ph == 1) atomic_addf(&p.O1[o1 + e], o);
    }
  }
}
constexpr long N_HGOUT = (long)ML * 8;
HD void body_hg_out(const Params& p, long gid) {
  long m = gid / 8;
  int h = (int)(gid % 8);
  long o1 = m * 1024 + h * 128;
  float ss = 0.f;
  for (int i = 0; i < 128; i++) ss += p.O1[o1 + i] * p.O1[o1 + i];
  float rstd = 1.0f / sqrtf(ss / 128 + NORM_EPS);
  for (int i = 0; i < 128; i++) {
    int c = 1024 + h * 128 + i;
    p.YALL[m * 2048 + c] = f2bf(p.O1[o1 + i] * rstd * p.hg_norm_w[i] * bf2f(p.G1[m * 2048 + c]));
  }
}

HD void body_final(const Params& p, long m) {
  float* x = p.out + m * D;
  float ss = 0.f;
  for (int k = 0; k < D; k++) ss += x[k] * x[k];
  float rstd = 1.0f / sqrtf(ss / D + NORM_EPS);
  for (int k = 0; k < D; k++) x[k] = x[k] * rstd * p.final_norm_w[k];
}

struct WsMap {
  size_t total;
};
HD size_t al256(size_t x) { return (x + 255) & ~(size_t)255; }
inline size_t setup_ws(Params& p, unsigned char* ws, unsigned char* outbuf) {
  size_t o = 0;
  auto take = [&](size_t bytes) {
    unsigned char* r = ws + o;
    o += al256(bytes);
    return r;
  };
  p.mod = (float*)take(sizeof(float) * 2 * NMOD * D3);
  p.H = (bf16*)take(2L * M * (D > 2048 ? D : 2048));
  p.YALL = p.H;
  p.XC1 = (float*)take(4L * MC * D);
  size_t mark = o;
  p.QKV0 = (bf16*)take(2L * M * 3072);
  p.G0 = (bf16*)take(2L * M * 2048);
  p.LR = (float*)take(4L * M * 256);
  p.KN = (float*)take(4L * M * 16);
  p.R = (bf16*)take(2L * M * 1024);
  p.V = (bf16*)take(2L * M * 1024);
  p.KK = (bf16*)take(2L * M * 1024);
  p.KD = (bf16*)take(2L * 2 * M * 1024);
  p.BB = (bf16*)take(2L * 2 * M * 1024);
  p.E = (bf16*)take(2L * 2 * M * 1024);
  size_t end0 = o;
  p.U0 = (bf16*)outbuf;
  p.Y = (float*)outbuf;
  o = mark;
  p.CQKV = (bf16*)take(2L * M * 1088);
  p.HGQ = (bf16*)take(2L * M * 1024);
  p.HGI = (bf16*)take(2L * M * 1024);
  p.HGF = (bf16*)take(2L * 2 * M * 1024);
  p.G1 = (bf16*)take(2L * ML * 2048);
  p.CQN = (bf16*)take(2L * ML * 512);
  p.CKVN = (bf16*)take(2L * M * 512);
  p.KPE = (bf16*)take(2L * M * 64);
  p.Q = (bf16*)take(2L * ML * 1536);
  p.KV = (bf16*)take(2L * M * 2048);
  p.O1 = (float*)take(4L * ML * 1024);
  size_t end1 = o;
  return end0 > end1 ? end0 : end1;
}

#ifndef HOST_TEST
typedef __attribute__((ext_vector_type(8))) short bf16x8;
typedef __attribute__((ext_vector_type(16))) float f32x16;

constexpr int GBM = 128, GBN = 128, GBK = 32, GLD = 40;
constexpr int SMEM_BYTES = 2 * 128 * GLD * 2;

__device__ __forceinline__ unsigned pack_bf2(float lo, float hi) { return (unsigned)f2bf(lo) | ((unsigned)f2bf(hi) << 16); }

template <class Epi>
__device__ __forceinline__ void gemm_phase(const bf16* __restrict__ A, int lda, const float* __restrict__ B, int ldb, int Mr, int N, int K, Epi epi,
                           int bid, int nb, unsigned char* smem) {
  bf16* As = (bf16*)smem;
  bf16* Bs = As + 128 * GLD;
  const int tid = threadIdx.x, lane = tid & 63, wid = tid >> 6;
  const int wm = wid >> 1, wn = wid & 1;
  const int tilesM = Mr / GBM, tilesN = (N + GBN - 1) / GBN;
  const int nk = K / GBK;
  const int arow = tid >> 1, akh = (tid & 1) * 16;
  const int bn = tid & 127, bkh = (tid >> 7) * 16;
  for (int tile = bid; tile < tilesM * tilesN; tile += nb) {
    const int tm = tile % tilesM, tn = tile / tilesM;
    const int m0 = tm * GBM, n0 = tn * GBN;
    f32x16 acc[2][2];
#pragma unroll
    for (int i = 0; i < 2; i++)
#pragma unroll
      for (int j = 0; j < 2; j++)
#pragma unroll
        for (int r = 0; r < 16; r++) acc[i][j][r] = 0.f;
    const bf16* ap = A + (long)(m0 + arow) * lda + akh;
    const bool bok = (n0 + bn) < N;
    const float* bp = B + (long)bkh * ldb + (bok ? (n0 + bn) : 0);
    uint4 ra0, ra1;
    float rb[16];
    ra0 = *(const uint4*)(ap);
    ra1 = *(const uint4*)(ap + 8);
#pragma unroll
    for (int i = 0; i < 16; i++) rb[i] = bok ? bp[(long)i * ldb] : 0.f;
    for (int kt = 0; kt < nk; kt++) {
      __syncthreads();
      *(uint4*)(As + arow * GLD + akh) = ra0;
      *(uint4*)(As + arow * GLD + akh + 8) = ra1;
      uint4 w0, w1;
      w0.x = pack_bf2(rb[0], rb[1]);
      w0.y = pack_bf2(rb[2], rb[3]);
      w0.z = pack_bf2(rb[4], rb[5]);
      w0.w = pack_bf2(rb[6], rb[7]);
      w1.x = pack_bf2(rb[8], rb[9]);
      w1.y = pack_bf2(rb[10], rb[11]);
      w1.z = pack_bf2(rb[12], rb[13]);
      w1.w = pack_bf2(rb[14], rb[15]);
      *(uint4*)(Bs + bn * GLD + bkh) = w0;
      *(uint4*)(Bs + bn * GLD + bkh + 8) = w1;
      __syncthreads();
      if (kt + 1 < nk) {
        const bf16* ap2 = ap + (long)(kt + 1) * GBK;
        ra0 = *(const uint4*)(ap2);
        ra1 = *(const uint4*)(ap2 + 8);
        const float* bp2 = bp + (long)(kt + 1) * GBK * ldb;
#pragma unroll
        for (int i = 0; i < 16; i++) rb[i] = bok ? bp2[(long)i * ldb] : 0.f;
      }
#pragma unroll
      for (int kk = 0; kk < 2; kk++) {
        bf16x8 af[2], bfr[2];
#pragma unroll
        for (int i = 0; i < 2; i++) af[i] = *(const bf16x8*)(As + (wm * 64 + i * 32 + (lane & 31)) * GLD + kk * 16 + (lane >> 5) * 8);
#pragma unroll
        for (int j = 0; j < 2; j++) bfr[j] = *(const bf16x8*)(Bs + (wn * 64 + j * 32 + (lane & 31)) * GLD + kk * 16 + (lane >> 5) * 8);
#pragma unroll
        for (int i = 0; i < 2; i++)
#pragma unroll
          for (int j = 0; j < 2; j++) acc[i][j] = __builtin_amdgcn_mfma_f32_32x32x16_bf16(af[i], bfr[j], acc[i][j], 0, 0, 0);
      }
    }
#pragma unroll
    for (int i = 0; i < 2; i++)
#pragma unroll
      for (int j = 0; j < 2; j++) {
        const int n = n0 + wn * 64 + j * 32 + (lane & 31);
        if (n < N) {
#pragma unroll
          for (int r = 0; r < 16; r++) {
            const int m = m0 + wm * 64 + i * 32 + (r & 3) + 8 * (r >> 2) + 4 * (lane >> 5);
            epi(m, n, acc[i][j][r]);
          }
        }
      }
  }
}

#define FOR_ITEMS(g, N) for (long g = (long)bid * 256 + threadIdx.x; g < (long)(N); g += (long)nb * 256)

constexpr int NPHASES = 17;
template <int PH>
__device__ __forceinline__ void run_phase(const Params& p, int bid, int nb, unsigned char* smem) {
  if constexpr (PH == 0) { FOR_ITEMS(g, N_ADALN) body_adaln(p, g); }
  if constexpr (PH == 1) { FOR_ITEMS(g, M) body_normmod(p, 0, g); }
  if constexpr (PH == 2) gemm_phase(p.H, D, p.e_w_in, EVEN_IN, M, EVEN_IN, D, EpiIn0{p}, bid, nb, smem);
  if constexpr (PH == 3) {
    FOR_ITEMS(g, N_LR) body_rwkv_lr(p, g);
    FOR_ITEMS(g, N_KN) body_rwkv_kn(p, g);
  }
  if constexpr (PH == 4) {
    FOR_ITEMS(g, N_TERMS) body_rwkv_terms(p, g);
    FOR_ITEMS(g, N_NA) body_na(p, g);
  }
  if constexpr (PH == 5) { FOR_ITEMS(g, (long)M * 1024) p.Y[g] = 0.f; }
  if constexpr (PH == 6) { FOR_ITEMS(g, N_RWSCAN) body_rwkv_scan(p, g); }
  if constexpr (PH == 7) { FOR_ITEMS(g, N_RWOUT) body_rwkv_out(p, g); }
  if constexpr (PH == 8) gemm_phase(p.YALL, 2048, p.e_w_out, D, M, D, 2048, EpiOut0{p}, bid, nb, smem);
  if constexpr (PH == 9) { FOR_ITEMS(g, M) body_normmod(p, 1, g); }
  if constexpr (PH == 10) gemm_phase(p.H, D, p.o_w_in, ODD_IN, M, ODD_IN, D, EpiIn1{p}, bid, nb, smem);
  if constexpr (PH == 11) {
    FOR_ITEMS(g, M) body_mla_prep(p, g);
    FOR_ITEMS(g, (long)ML * 1024) p.O1[g] = 0.f;
  }
  if constexpr (PH == 12) {
    gemm_phase(p.CQN, 512, p.mla_w_uq, 1536, ML, 1536, 512, EpiQ{p}, bid, nb, smem);
    gemm_phase(p.CKVN, 512, p.mla_w_ukv, 2048, M, 2048, 512, EpiKV{p}, bid, nb, smem);
  }
  if constexpr (PH == 13) {
    FOR_ITEMS(g, N_ROPEQ) body_rope_q(p, g);
    FOR_ITEMS(g, N_HGSCAN) body_hg_scan(p, g);
  }
  if constexpr (PH == 14) {
    FOR_ITEMS(g, N_MLA) body_mla(p, g);
    FOR_ITEMS(g, N_HGOUT) body_hg_out(p, g);
  }
  if constexpr (PH == 15) gemm_phase(p.YALL, 2048, p.o_w_out, D, ML, D, 2048, EpiOut1{p}, bid, nb, smem);
  if constexpr (PH == 16) { FOR_ITEMS(g, ML) body_final(p, g); }
}

#if FUSED
template <int PH>
__device__ __forceinline__ void run_from(const Params& p, cg::grid_group& grid, unsigned char* smem) {
  run_phase<PH>(p, blockIdx.x, gridDim.x, smem);
  if constexpr (PH + 1 < NPHASES) {
    grid.sync();
    run_from<PH + 1>(p, grid, smem);
  }
}
__global__ void __launch_bounds__(256) mega_kernel(const Params p) {
  __shared__ __attribute__((aligned(16))) unsigned char smem[SMEM_BYTES];
  cg::grid_group grid = cg::this_grid();
  run_from<0>(p, grid, smem);
}
#else
template <int PH>
__global__ void __launch_bounds__(256) phase_kernel(const Params p) {
  __shared__ __attribute__((aligned(16))) unsigned char smem[SMEM_BYTES];
  run_phase<PH>(p, blockIdx.x, gridDim.x, smem);
}
template <int PH>
static void launch_from(const Params& p, hipStream_t stream) {
  phase_kernel<PH><<<dim3(1024), dim3(256), 0, stream>>>(p);
  if constexpr (PH + 1 < NPHASES) launch_from<PH + 1>(p, stream);
}
#endif

extern "C" void kernel_launch(void* const* d_in, const int* in_sizes, int n_in, void* d_out, int out_size, void* d_ws, size_t ws_size,
                              hipStream_t stream) {
  Params p;
  memset(&p, 0, sizeof(p));
  const float** f = (const float**)&p;
  for (int i = 0; i < 29; i++) f[i] = (const float*)d_in[i];
  p.out = (float*)d_out;
  setup_ws(p, (unsigned char*)d_ws, (unsigned char*)d_out);
#if FUSED
  static int grid_blocks = 0;
  if (!grid_blocks) {
    int dev = 0, cus = 0, per_cu = 0;
    (void)hipGetDevice(&dev);
    (void)hipDeviceGetAttribute(&cus, hipDeviceAttributeMultiprocessorCount, dev);
    (void)hipOccupancyMaxActiveBlocksPerMultiprocessor(&per_cu, mega_kernel, 256, 0);
    if (per_cu > 2) per_cu = 2;
    grid_blocks = cus * per_cu;
  }
  void* args[] = {(void*)&p};
  hipError_t e = hipLaunchCooperativeKernel((void*)mega_kernel, dim3(grid_blocks), dim3(256), args, 0, stream);
  if (e != hipSuccess) fprintf(stderr, "cooperative launch failed: %s (grid %d)\n", hipGetErrorString(e), grid_blocks);
#else
  launch_from<0>(p, stream);
#endif
}
#endif
```

```cpp
#ifndef HOST_TEST
#include <hip/hip_runtime.h>
#include <hip/hip_cooperative_groups.h>
#include <cstdio>
#include <cstring>
namespace cg = cooperative_groups;
#define HD __host__ __device__ __forceinline__
#else
#include <cmath>
#include <cstdio>
#include <cstdlib>
#include <cstring>
#define HD inline
#endif

#ifndef FUSED
#define FUSED 1
#endif

typedef unsigned short bf16;

#ifdef HOST_TEST
constexpr int D = HT_D, BATCH = HT_B, SEQ = HT_SEQ, CTX = HT_CTX;
#else
constexpr int D = 2048, BATCH = 4, SEQ = 2048, CTX = 256;
#endif
constexpr int ML = BATCH * SEQ;
constexpr int MC = BATCH * CTX;
constexpr int M = ML + MC;
constexpr int GW = 64, ROWS = SEQ / GW;
constexpr int D3 = 3 * D;
constexpr int EVEN_IN = 8448, ODD_IN = 7232;
constexpr int NMOD = BATCH + 1;
constexpr float NORM_EPS = 1e-6f;

struct Params {
  const float *x, *c, *ctx, *c_ctx, *ada_w, *ada_b, *norm_w, *e_w_in, *e_w_out, *na_rpb, *rw_mu, *rw_w0, *rw_w2, *rw_a0, *rw_a2,
      *rw_k_k, *rw_k_a, *rw_r_k, *rw_ln_w, *rw_ln_b, *o_w_in, *o_w_out, *mla_q_norm, *mla_w_uq, *mla_kv_norm, *mla_w_ukv, *hg_lb,
      *hg_norm_w, *final_norm_w;
  float* out;
  float* mod;
  bf16* H;
  bf16* YALL;
  float* XC1;
  bf16* QKV0;
  bf16* G0;
  bf16* U0;
  float* Y;
  float* LR;
  float* KN;
  bf16 *R, *V, *KK;
  bf16 *KD, *BB, *E;
  bf16* CQKV;
  bf16 *HGQ, *HGI;
  bf16* HGF;
  bf16* G1;
  bf16 *CQN;
  bf16 *CKVN;
  bf16* KPE;
  bf16* Q;
  bf16* KV;
  float* O1;
};

HD float bf2f(bf16 v) {
  union { unsigned u; float f; } x;
  x.u = ((unsigned)v) << 16;
  return x.f;
}
HD bf16 f2bf(float f) {
  union { unsigned u; float f; } x;
  x.f = f;
  unsigned r = x.u + 0x7FFFu + ((x.u >> 16) & 1u);
  return (bf16)(r >> 16);
}
HD float sigmoidf_(float x) { return 1.0f / (1.0f + expf(-x)); }
HD float siluf_(float x) { return x / (1.0f + expf(-x)); }
HD int clampi(int v, int lo, int hi) { return v < lo ? lo : (v > hi ? hi : v); }

#if defined(__HIP_DEVICE_COMPILE__)
#define UNIFORM(x) __builtin_amdgcn_readfirstlane(x)
#else
#define UNIFORM(x) (x)
#endif

HD void atomic_addf(float* p, float v) {
#if defined(__HIP_DEVICE_COMPILE__)
  atomicAdd(p, v);
#elif defined(HOST_TEST)
#pragma omp atomic
  *p += v;
#else
  *p += v;
#endif
}

constexpr long N_ADALN = 2L * D3;
HD void body_adaln(const Params& p, long gid) {
  int l = (int)(gid / D3), j = (int)(gid % D3);
  float acc[NMOD];
#pragma unroll
  for (int r = 0; r < NMOD; r++) acc[r] = 0.f;
  const float* w = p.ada_w + (long)l * D * D3 + j;
  for (int k = 0; k < D; k++) {
    float wv = w[(long)k * D3];
#pragma unroll
    for (int r = 0; r < NMOD; r++) {
      float cv = (r < BATCH) ? p.c[r * D + k] : p.c_ctx[k];
      acc[r] += siluf_(cv) * wv;
    }
  }
#pragma unroll
  for (int r = 0; r < NMOD; r++) p.mod[((long)l * NMOD + r) * D3 + j] = acc[r] + p.ada_b[l * D3 + j];
}

HD void body_normmod(const Params& p, int l, long m) {
  const float* src;
  int r;
  if (m < ML) {
    src = (l == 0 ? p.x : p.out) + m * D;
    r = (int)(m / SEQ);
  } else {
    src = (l == 0 ? p.ctx : p.XC1) + (m - ML) * D;
    r = BATCH;
  }
  float ss = 0.f;
  for (int k = 0; k < D; k++) ss += src[k] * src[k];
  float rstd = 1.0f / sqrtf(ss / D + NORM_EPS);
  const float* md = p.mod + ((long)l * NMOD + r) * D3;
  const float* nw = p.norm_w + l * D;
  for (int k = 0; k < D; k++) p.H[m * D + k] = f2bf(src[k] * rstd * nw[k] * (1.0f + md[D + k]) + md[k]);
}

struct EpiIn0 {
  const Params p_;
  HD void operator()(int m, int n, float v) const {
    if (n < 3072) p_.QKV0[(long)m * 3072 + n] = f2bf(v);
    else if (n < 6400) p_.U0[(long)m * 3328 + (n - 3072)] = f2bf(v);
    else p_.G0[(long)m * 2048 + (n - 6400)] = f2bf(siluf_(v));
  }
};
struct EpiOut0 {
  const Params p_;
  HD void operator()(int m, int n, float v) const {
    if (m < ML) {
      int b = m / SEQ;
      p_.out[(long)m * D + n] = p_.x[(long)m * D + n] + p_.mod[((long)0 * NMOD + b) * D3 + 2 * D + n] * v;
    } else {
      p_.XC1[(long)(m - ML) * D + n] = p_.ctx[(long)(m - ML) * D + n] + p_.mod[((long)0 * NMOD + BATCH) * D3 + 2 * D + n] * v;
    }
  }
};
struct EpiIn1 {
  const Params p_;
  HD void operator()(int m, int n, float v) const {
    if (n < 1088) p_.CQKV[(long)m * 1088 + n] = f2bf(v);
    else if (n < 2112) p_.HGQ[(long)m * 1024 + (n - 1088)] = f2bf(v);
    else if (n < 3136) p_.HGF[(long)m * 1024 + (n - 2112)] = f2bf(v);
    else if (n < 4160) p_.HGF[((long)M + m) * 1024 + (n - 3136)] = f2bf(v);
    else if (n < 5184) p_.HGI[(long)m * 1024 + (n - 4160)] = f2bf(v);
    else if (m < ML) p_.G1[(long)m * 2048 + (n - 5184)] = f2bf(siluf_(v));
  }
};
struct EpiQ {
  const Params p_;
  HD void operator()(int m, int n, float v) const { p_.Q[(long)m * 1536 + n] = f2bf(v); }
};
struct EpiKV {
  const Params p_;
  HD void operator()(int m, int n, float v) const { p_.KV[(long)m * 2048 + n] = f2bf(v); }
};
struct EpiOut1 {
  const Params p_;
  HD void operator()(int m, int n, float v) const {
    int b = m / SEQ;
    p_.out[(long)m * D + n] += p_.mod[((long)1 * NMOD + b) * D3 + 2 * D + n] * v;
  }
};

HD float ushift(const Params& p, long m, int c) {
  bool first, last;
  if (m < ML) {
    int t = (int)(m % SEQ);
    first = (t == 0);
    last = (t == SEQ - 1);
  } else {
    int t = (int)((m - ML) % CTX);
    first = (t == 0);
    last = (t == CTX - 1);
  }
  float u = bf2f(p.U0[m * 3328 + c]);
  float pv = first ? 0.f : bf2f(p.U0[(m - 1) * 3328 + c]);
  float nx = last ? 0.f : bf2f(p.U0[(m + 1) * 3328 + c]);
  return u + p.rw_mu[c] * (pv - u) + p.rw_mu[3328 + c] * (nx - u);
}

constexpr long N_LR = (long)M * 256;
HD void body_rwkv_lr(const Params& p, long gid) {
  long m = gid / 256;
  int j = (int)(gid % 256);
  float v = ushift(p, m, 3072 + j);
  p.LR[gid] = (j < 128) ? tanhf(v) : v;
}
constexpr long N_KN = (long)M * 16;
HD void body_rwkv_kn(const Params& p, long gid) {
  long m = gid / 16;
  int h = (int)(gid % 16);
  float ss = 0.f;
  for (int i = 0; i < 64; i++) {
    int c = h * 64 + i;
    float k = ushift(p, m, 1024 + c) * p.rw_k_k[c];
    ss += k * k;
  }
  p.KN[gid] = 1.0f / fmaxf(sqrtf(ss), 1e-12f);
}
constexpr long N_TERMS = (long)M * 1024;
HD void body_rwkv_terms(const Params& p, long gid) {
  long m = gid / 1024;
  int c = (int)(gid % 1024);
  float r = ushift(p, m, c), k = ushift(p, m, 1024 + c), v = ushift(p, m, 2048 + c);
  float kk = k * p.rw_k_k[c] * p.KN[m * 16 + (c >> 6)];
  p.R[gid] = f2bf(r);
  p.V[gid] = f2bf(v);
  p.KK[gid] = f2bf(kk);
  const float* lr = p.LR + m * 256;
#pragma unroll
  for (int d = 0; d < 2; d++) {
    float w = p.rw_w0[d * 1024 + c], a = p.rw_a0[d * 1024 + c];
    const float* w2 = p.rw_w2 + (long)d * 64 * 1024 + c;
    const float* a2 = p.rw_a2 + (long)d * 64 * 1024 + c;
    for (int j = 0; j < 64; j++) {
      w += lr[d * 64 + j] * w2[j * 1024];
      a += lr[128 + d * 64 + j] * a2[j * 1024];
    }
    float e = sigmoidf_(w) * 0.60653065971263342f;
    a = sigmoidf_(a);
    float kd = k * (1.0f + (a - 1.0f) * p.rw_k_a[c]);
    long o = (long)d * M * 1024 + gid;
    p.E[o] = f2bf(e);
    p.KD[o] = f2bf(kd);
    p.BB[o] = f2bf(kk * a);
  }
}

constexpr long N_NA = 4L * 8 * M;
HD void body_na(const Params& p, long gid) {
  long m = gid % M;
  int h = (int)((gid / M) % 8);
  int dc = (int)(gid / ((long)M * 8));
  const bf16* q = p.QKV0 + m * 3072 + h * 128;
  const float scale = 0.08838834764831845f;
  float o[32];
#pragma unroll
  for (int i = 0; i < 32; i++) o[i] = 0.f;
  float mx = -1e30f, l = 0.f;
  int b;
  int nloc = 0, r = 0, j = 0, r0 = 0, c0 = 0;
  if (m < ML) {
    b = (int)(m / SEQ);
    int t = (int)(m % SEQ);
    r = t / GW;
    j = t % GW;
    r0 = clampi(r - 4, 0, ROWS - 8);
    c0 = clampi(j - 8, 0, GW - 16);
    nloc = 128;
  } else {
    b = (int)((m - ML) / CTX);
  }
  for (int kidx = 0; kidx < nloc + CTX; kidx++) {
    long mk;
    float bias = 0.f;
    if (kidx < nloc) {
      int a = kidx >> 4, kx = kidx & 15;
      mk = (long)b * SEQ + (r0 + a) * GW + c0 + kx;
      bias = p.na_rpb[(h * 15 + (r0 + a - r + 7)) * 31 + (c0 + kx - j + 15)];
    } else {
      mk = ML + (long)b * CTX + (kidx - nloc);
    }
    const bf16* kp = p.QKV0 + mk * 3072 + 1024 + h * 128;
    float s = 0.f;
    for (int d = 0; d < 128; d++) s += bf2f(q[d]) * bf2f(kp[d]);
    s = s * scale + bias;
    if (s > mx) {
      float f = expf(mx - s);
      l *= f;
#pragma unroll
      for (int i = 0; i < 32; i++) o[i] *= f;
      mx = s;
    }
    float pe = expf(s - mx);
    l += pe;
    const bf16* vp = p.QKV0 + mk * 3072 + 2048 + h * 128 + dc * 32;
#pragma unroll
    for (int i = 0; i < 32; i++) o[i] += pe * bf2f(vp[i]);
  }
  float inv = 1.0f / l;
  int col = h * 128 + dc * 32;
#pragma unroll
  for (int i = 0; i < 32; i++) p.YALL[m * 2048 + col + i] = f2bf(o[i] * inv * bf2f(p.G0[m * 2048 + col + i]));
}

constexpr long N_RWSCAN = 2L * BATCH * 16 * 64;
HD void body_rwkv_scan(const Params& p, long gid) {
  int v = (int)(gid % 64);
  int h = UNIFORM((int)((gid / 64) % 16));
  int b = UNIFORM((int)((gid / 1024) % BATCH));
  int d = UNIFORM((int)(gid / (1024L * BATCH)));
  float S[64];
#pragma unroll
  for (int i = 0; i < 64; i++) S[i] = 0.f;
  for (int ph = 0; ph < 2; ph++) {
    int Tn = ph == 0 ? CTX : SEQ;
    long base = ph == 0 ? (ML + (long)b * CTX) : ((long)b * SEQ);
    for (int s = 0; s < Tn; s++) {
      int t = d == 0 ? s : Tn - 1 - s;
      long m = base + t;
      long o1 = m * 1024 + h * 64;
      long o2 = (long)d * M * 1024 + o1;
      float vv = bf2f(p.V[o1 + v]);
      float sa = 0.f;
#pragma unroll
      for (int i = 0; i < 64; i++) sa -= S[i] * bf2f(p.KK[o1 + i]);
      float y = 0.f;
#pragma unroll
      for (int i = 0; i < 64; i++) {
        float w = expf(-bf2f(p.E[o2 + i]));
        float sn = S[i] * w + sa * bf2f(p.BB[o2 + i]) + vv * bf2f(p.KD[o2 + i]);
        S[i] = sn;
        y += sn * bf2f(p.R[o1 + i]);
      }
      atomic_addf(&p.Y[o1 + v], y);
    }
  }
}

constexpr long N_RWOUT = (long)M * 16;
HD void body_rwkv_out(const Params& p, long gid) {
  long m = gid / 16;
  int h = (int)(gid % 16);
  long o1 = m * 1024 + h * 64;
  float mu = 0.f;
  for (int i = 0; i < 64; i++) mu += p.Y[o1 + i];
  mu *= (1.0f / 64);
  float var = 0.f, bonus = 0.f;
  for (int i = 0; i < 64; i++) {
    float dlt = p.Y[o1 + i] - mu;
    var += dlt * dlt;
    float kd = bf2f(p.KD[o1 + i]) + bf2f(p.KD[(long)M * 1024 + o1 + i]);
    bonus += bf2f(p.R[o1 + i]) * kd * p.rw_r_k[h * 64 + i];
  }
  float rs = 1.0f / sqrtf(var * (1.0f / 64) + 64e-5f);
  for (int i = 0; i < 64; i++) {
    int c = h * 64 + i;
    float yn = (p.Y[o1 + i] - mu) * rs * p.rw_ln_w[c] + p.rw_ln_b[c] + bonus * bf2f(p.V[o1 + i]);
    p.YALL[m * 2048 + 1024 + c] = f2bf(yn * bf2f(p.G0[m * 2048 + 1024 + c]));
  }
}

HD void rope_angle(int t, int i, float& cs, float& sn) {
  int f = i & 15;
  float pos = (float)((i < 16) ? (t / GW) : (t % GW));
  float inv = powf(10000.0f, -(float)f / 16.0f);
  float ang = pos * inv;
  cs = cosf(ang);
  sn = sinf(ang);
}
HD void body_mla_prep(const Params& p, long m) {
  const bf16* z = p.CQKV + m * 1088;
  if (m < ML) {
    float ss = 0.f;
    for (int k = 0; k < 512; k++) ss += bf2f(z[k]) * bf2f(z[k]);
    float rstd = 1.0f / sqrtf(ss / 512 + NORM_EPS);
    for (int k = 0; k < 512; k++) p.CQN[m * 512 + k] = f2bf(bf2f(z[k]) * rstd * p.mla_q_norm[k]);
  }
  {
    float ss = 0.f;
    for (int k = 0; k < 512; k++) ss += bf2f(z[512 + k]) * bf2f(z[512 + k]);
    float rstd = 1.0f / sqrtf(ss / 512 + NORM_EPS);
    for (int k = 0; k < 512; k++) p.CKVN[m * 512 + k] = f2bf(bf2f(z[512 + k]) * rstd * p.mla_kv_norm[k]);
  }
  for (int i = 0; i < 32; i++) {
    float x0 = bf2f(z[1024 + 2 * i]), x1 = bf2f(z[1024 + 2 * i + 1]);
    if (m < ML) {
      float cs, sn;
      rope_angle((int)(m % SEQ), i, cs, sn);
      float y0 = x0 * cs - x1 * sn, y1 = x0 * sn + x1 * cs;
      x0 = y0;
      x1 = y1;
    }
    p.KPE[m * 64 + 2 * i] = f2bf(x0);
    p.KPE[m * 64 + 2 * i + 1] = f2bf(x1);
  }
}
constexpr long N_ROPEQ = (long)ML * 8 * 32;
HD void body_rope_q(const Params& p, long gid) {
  int i = (int)(gid % 32);
  int h = (int)((gid / 32) % 8);
  long m = gid / 256;
  bf16* q = p.Q + m * 1536 + h * 192 + 128 + 2 * i;
  float cs, sn;
  rope_angle((int)(m % SEQ), i, cs, sn);
  float x0 = bf2f(q[0]), x1 = bf2f(q[1]);
  q[0] = f2bf(x0 * cs - x1 * sn);
  q[1] = f2bf(x0 * sn + x1 * cs);
}

constexpr long N_MLA = 4L * BATCH * 8 * SEQ;
HD void body_mla(const Params& p, long gid) {
  int t = (int)(gid % SEQ);
  int h = UNIFORM((int)((gid / SEQ) % 8));
  int b = UNIFORM((int)((gid / (8L * SEQ)) % BATCH));
  int dc = UNIFORM((int)(gid / (8L * SEQ * BATCH)));
  long m = (long)b * SEQ + t;
  const bf16* q = p.Q + m * 1536 + h * 192;
  const float scale = 0.07216878364870322f;
  float o[32];
#pragma unroll
  for (int i = 0; i < 32; i++) o[i] = 0.f;
  float mx = -1e30f, l = 0.f;
  for (int kidx = 0; kidx < SEQ + CTX; kidx++) {
    long mk = kidx < SEQ ? ((long)b * SEQ + kidx) : (ML + (long)b * CTX + (kidx - SEQ));
    const bf16* kn = p.KV + mk * 2048 + h * 256;
    const bf16* kp = p.KPE + mk * 64;
    float s = 0.f;
    for (int d = 0; d < 128; d++) s += bf2f(q[d]) * bf2f(kn[d]);
    for (int d = 0; d < 64; d++) s += bf2f(q[128 + d]) * bf2f(kp[d]);
    s *= scale;
    if (s > mx) {
      float f = expf(mx - s);
      l *= f;
#pragma unroll
      for (int i = 0; i < 32; i++) o[i] *= f;
      mx = s;
    }
    float pe = expf(s - mx);
    l += pe;
    const bf16* vp = kn + 128 + dc * 32;
#pragma unroll
    for (int i = 0; i < 32; i++) o[i] += pe * bf2f(vp[i]);
  }
  float inv = 1.0f / l;
  int col = h * 128 + dc * 32;
#pragma unroll
  for (int i = 0; i < 32; i++) p.YALL[m * 2048 + col + i] = f2bf(o[i] * inv * bf2f(p.G1[m * 2048 + col + i]));
}

constexpr long N_HGSCAN = 2L * BATCH * 8 * 128;
HD void body_hg_scan(const Params& p, long gid) {
  int e = (int)(gid % 128);
  int h = UNIFORM((int)((gid / 128) % 8));
  int b = UNIFORM((int)((gid / 1024) % BATCH));
  int d = UNIFORM((int)(gid / (1024L * BATCH)));
  float S[128];
#pragma unroll
  for (int i = 0; i < 128; i++) S[i] = 0.f;
  for (int ph = 0; ph < 2; ph++) {
    int Tn = ph == 0 ? CTX : SEQ;
    long base = ph == 0 ? (ML + (long)b * CTX) : ((long)b * SEQ);
    for (int s = 0; s < Tn; s++) {
      int t = d == 0 ? s : Tn - 1 - s;
      long m = base + t;
      long o1 = m * 1024 + h * 128;
      const bf16* fp = p.HGF + (long)d * M * 1024 + o1;
      float vv = bf2f(p.HGI[o1 + e]);
      float o = 0.f;
#pragma unroll
      for (int i = 0; i < 128; i++) {
        float h0 = p.hg_lb[h * 128 + i], h1 = p.hg_lb[1024 + h * 128 + i];
        float lb = 1.0f / (1.0f + expf(h0 - h1));
        float sg = sigmoidf_(bf2f(fp[i]));
        float f = lb + (1.0f - lb) * sg;
        float kk = (1.0f - lb) * (1.0f - sg);
        float sn = f * S[i] + kk * vv;
        S[i] = sn;
        o += bf2f(p.HGQ[o1 + i]) * sn;
      }
      if (ph == 1) atomic_addf(&p.O1[o1 + e], o);
    }
  }
}
constexpr long N_HGOUT = (long)ML * 8;
HD void body_hg_out(const Params& p, long gid) {
  long m = gid / 8;
  int h = (int)(gid % 8);
  long o1 = m * 1024 + h * 128;
  float ss = 0.f;
  for (int i = 0; i < 128; i++) ss += p.O1[o1 + i] * p.O1[o1 + i];
  float rstd = 1.0f / sqrtf(ss / 128 + NORM_EPS);
  for (int i = 0; i < 128; i++) {
    int c = 1024 + h * 128 + i;
    p.YALL[m * 2048 + c] = f2bf(p.O1[o1 + i] * rstd * p.hg_norm_w[i] * bf2f(p.G1[m * 2048 + c]));
  }
}

HD void body_final(const Params& p, long m) {
  float* x = p.out + m * D;
  float ss = 0.f;
  for (int k = 0; k < D; k++) ss += x[k] * x[k];
  float rstd = 1.0f / sqrtf(ss / D + NORM_EPS);
  for (int k = 0; k < D; k++) x[k] = x[k] * rstd * p.final_norm_w[k];
}

struct WsMap {
  size_t total;
};
HD size_t al256(size_t x) { return (x + 255) & ~(size_t)255; }
inline size_t setup_ws(Params& p, unsigned char* ws, unsigned char* outbuf) {
  size_t o = 0;
  auto take = [&](size_t bytes) {
    unsigned char* r = ws + o;
    o += al256(bytes);
    return r;
  };
  p.mod = (float*)take(sizeof(float) * 2 * NMOD * D3);
  p.H = (bf16*)take(2L * M * (D > 2048 ? D : 2048));
  p.YALL = p.H;
  p.XC1 = (float*)take(4L * MC * D);
  size_t mark = o;
  p.QKV0 = (bf16*)take(2L * M * 3072);
  p.G0 = (bf16*)take(2L * M * 2048);
  p.LR = (float*)take(4L * M * 256);
  p.KN = (float*)take(4L * M * 16);
  p.R = (bf16*)take(2L * M * 1024);
  p.V = (bf16*)take(2L * M * 1024);
  p.KK = (bf16*)take(2L * M * 1024);
  p.KD = (bf16*)take(2L * 2 * M * 1024);
  p.BB = (bf16*)take(2L * 2 * M * 1024);
  p.E = (bf16*)take(2L * 2 * M * 1024);
  size_t end0 = o;
  p.U0 = (bf16*)outbuf;
  p.Y = (float*)outbuf;
  o = mark;
  p.CQKV = (bf16*)take(2L * M * 1088);
  p.HGQ = (bf16*)take(2L * M * 1024);
  p.HGI = (bf16*)take(2L * M * 1024);
  p.HGF = (bf16*)take(2L * 2 * M * 1024);
  p.G1 = (bf16*)take(2L * ML * 2048);
  p.CQN = (bf16*)take(2L * ML * 512);
  p.CKVN = (bf16*)take(2L * M * 512);
  p.KPE = (bf16*)take(2L * M * 64);
  p.Q = (bf16*)take(2L * ML * 1536);
  p.KV = (bf16*)take(2L * M * 2048);
  p.O1 = (float*)take(4L * ML * 1024);
  size_t end1 = o;
  return end0 > end1 ? end0 : end1;
}

#ifndef HOST_TEST
typedef __attribute__((ext_vector_type(8))) short bf16x8;
typedef __attribute__((ext_vector_type(16))) float f32x16;

constexpr int GBM = 128, GBN = 128, GBK = 32, GLD = 40;
constexpr int SMEM_BYTES = 2 * 128 * GLD * 2;

__device__ __forceinline__ unsigned pack_bf2(float lo, float hi) { return (unsigned)f2bf(lo) | ((unsigned)f2bf(hi) << 16); }

template <class Epi>
__device__ __forceinline__ void gemm_phase(const bf16* __restrict__ A, int lda, const float* __restrict__ B, int ldb, int Mr, int N, int K, Epi epi,
                           int bid, int nb, unsigned char* smem) {
  bf16* As = (bf16*)smem;
  bf16* Bs = As + 128 * GLD;
  const int tid = threadIdx.x, lane = tid & 63, wid = tid >> 6;
  const int wm = wid >> 1, wn = wid & 1;
  const int tilesM = Mr / GBM, tilesN = (N + GBN - 1) / GBN;
  const int nk = K / GBK;
  const int arow = tid >> 1, akh = (tid & 1) * 16;
  const int bn = tid & 127, bkh = (tid >> 7) * 16;
  for (int tile = bid; tile < tilesM * tilesN; tile += nb) {
    const int tm = tile % tilesM, tn = tile / tilesM;
    const int m0 = tm * GBM, n0 = tn * GBN;
    f32x16 acc[2][2];
#pragma unroll
    for (int i = 0; i < 2; i++)
#pragma unroll
      for (int j = 0; j < 2; j++)
#pragma unroll
        for (int r = 0; r < 16; r++) acc[i][j][r] = 0.f;
    const bf16* ap = A + (long)(m0 + arow) * lda + akh;
    const bool bok = (n0 + bn) < N;
    const float* bp = B + (long)bkh * ldb + (bok ? (n0 + bn) : 0);
    uint4 ra0, ra1;
    float rb[16];
    ra0 = *(const uint4*)(ap);
    ra1 = *(const uint4*)(ap + 8);
#pragma unroll
    for (int i = 0; i < 16; i++) rb[i] = bok ? bp[(long)i * ldb] : 0.f;
    for (int kt = 0; kt < nk; kt++) {
      __syncthreads();
      *(uint4*)(As + arow * GLD + akh) = ra0;
      *(uint4*)(As + arow * GLD + akh + 8) = ra1;
      uint4 w0, w1;
      w0.x = pack_bf2(rb[0], rb[1]);
      w0.y = pack_bf2(rb[2], rb[3]);
      w0.z = pack_bf2(rb[4], rb[5]);
      w0.w = pack_bf2(rb[6], rb[7]);
      w1.x = pack_bf2(rb[8], rb[9]);
      w1.y = pack_bf2(rb[10], rb[11]);
      w1.z = pack_bf2(rb[12], rb[13]);
      w1.w = pack_bf2(rb[14], rb[15]);
      *(uint4*)(Bs + bn * GLD + bkh) = w0;
      *(uint4*)(Bs + bn * GLD + bkh + 8) = w1;
      __syncthreads();
      if (kt + 1 < nk) {
        const bf16* ap2 = ap + (long)(kt + 1) * GBK;
        ra0 = *(const uint4*)(ap2);
        ra1 = *(const uint4*)(ap2 + 8);
        const float* bp2 = bp + (long)(kt + 1) * GBK * ldb;
#pragma unroll
        for (int i = 0; i < 16; i++) rb[i] = bok ? bp2[(long)i * ldb] : 0.f;
      }
#pragma unroll
      for (int kk = 0; kk < 2; kk++) {
        bf16x8 af[2], bfr[2];
#pragma unroll
        for (int i = 0; i < 2; i++) af[i] = *(const bf16x8*)(As + (wm * 64 + i * 32 + (lane & 31)) * GLD + kk * 16 + (lane >> 5) * 8);
#pragma unroll
        for (int j = 0; j < 2; j++) bfr[j] = *(const bf16x8*)(Bs + (wn * 64 + j * 32 + (lane & 31)) * GLD + kk * 16 + (lane >> 5) * 8);
#pragma unroll
        for (int i = 0; i < 2; i++)
#pragma unroll
          for (int j = 0; j < 2; j++) acc[i][j] = __builtin_amdgcn_mfma_f32_32x32x16_bf16(af[i], bfr[j], acc[i][j], 0, 0, 0);
      }
    }
#pragma unroll
    for (int i = 0; i < 2; i++)
#pragma unroll
      for (int j = 0; j < 2; j++) {
        const int n = n0 + wn * 64 + j * 32 + (lane & 31);
        if (n < N) {
#pragma unroll
          for (int r = 0; r < 16; r++) {
            const int m = m0 + wm * 64 + i * 32 + (r & 3) + 8 * (r >> 2) + 4 * (lane >> 5);
            epi(m, n, acc[i][j][r]);
          }
        }
      }
  }
}

#define FOR_ITEMS(g, N) for (long g = (long)bid * 256 + threadIdx.x; g < (long)(N); g += (long)nb * 256)

constexpr int NPHASES = 17;
template <int PH>
__device__ __forceinline__ void run_phase(const Params& p, int bid, int nb, unsigned char* smem) {
  if constexpr (PH == 0) { FOR_ITEMS(g, N_ADALN) body_adaln(p, g); }
  if constexpr (PH == 1) { FOR_ITEMS(g, M) body_normmod(p, 0, g); }
  if constexpr (PH == 2) gemm_phase(p.H, D, p.e_w_in, EVEN_IN, M, EVEN_IN, D, EpiIn0{p}, bid, nb, smem);
  if constexpr (PH == 3) {
    FOR_ITEMS(g, N_LR) body_rwkv_lr(p, g);
    FOR_ITEMS(g, N_KN) body_rwkv_kn(p, g);
  }
  if constexpr (PH == 4) {
    FOR_ITEMS(g, N_TERMS) body_rwkv_terms(p, g);
    FOR_ITEMS(g, N_NA) body_na(p, g);
  }
  if constexpr (PH == 5) { FOR_ITEMS(g, (long)M * 1024) p.Y[g] = 0.f; }
  if constexpr (PH == 6) { FOR_ITEMS(g, N_RWSCAN) body_rwkv_scan(p, g); }
  if constexpr (PH == 7) { FOR_ITEMS(g, N_RWOUT) body_rwkv_out(p, g); }
  if constexpr (PH == 8) gemm_phase(p.YALL, 2048, p.e_w_out, D, M, D, 2048, EpiOut0{p}, bid, nb, smem);
  if constexpr (PH == 9) { FOR_ITEMS(g, M) body_normmod(p, 1, g); }
  if constexpr (PH == 10) gemm_phase(p.H, D, p.o_w_in, ODD_IN, M, ODD_IN, D, EpiIn1{p}, bid, nb, smem);
  if constexpr (PH == 11) {
    FOR_ITEMS(g, M) body_mla_prep(p, g);
    FOR_ITEMS(g, (long)ML * 1024) p.O1[g] = 0.f;
  }
  if constexpr (PH == 12) {
    gemm_phase(p.CQN, 512, p.mla_w_uq, 1536, ML, 1536, 512, EpiQ{p}, bid, nb, smem);
    gemm_phase(p.CKVN, 512, p.mla_w_ukv, 2048, M, 2048, 512, EpiKV{p}, bid, nb, smem);
  }
  if constexpr (PH == 13) {
    FOR_ITEMS(g, N_ROPEQ) body_rope_q(p, g);
    FOR_ITEMS(g, N_HGSCAN) body_hg_scan(p, g);
  }
  if constexpr (PH == 14) {
    FOR_ITEMS(g, N_MLA) body_mla(p, g);
    FOR_ITEMS(g, N_HGOUT) body_hg_out(p, g);
  }
  if constexpr (PH == 15) gemm_phase(p.YALL, 2048, p.o_w_out, D, ML, D, 2048, EpiOut1{p}, bid, nb, smem);
  if constexpr (PH == 16) { FOR_ITEMS(g, ML) body_final(p, g); }
}

#if FUSED
template <int PH>
__device__ __forceinline__ void run_from(const Params& p, cg::grid_group& grid, unsigned char* smem) {
  run_phase<PH>(p, blockIdx.x, gridDim.x, smem);
  if constexpr (PH + 1 < NPHASES) {
    grid.sync();
    run_from<PH + 1>(p, grid, smem);
  }
}
__global__ void __launch_bounds__(256) mega_kernel(const Params p) {
  __shared__ __attribute__((aligned(16))) unsigned char smem[SMEM_BYTES];
  cg::grid_group grid = cg::this_grid();
  run_from<0>(p, grid, smem);
}
#else
template <int PH>
__global__ void __launch_bounds__(256) phase_kernel(const Params p) {
  __shared__ __attribute__((aligned(16))) unsigned char smem[SMEM_BYTES];
  run_phase<PH>(p, blockIdx.x, gridDim.x, smem);
}
template <int PH>
static void launch_from(const Params& p, hipStream_t stream) {
  phase_kernel<PH><<<dim3(1024), dim3(256), 0, stream>>>(p);
  if constexpr (PH + 1 < NPHASES) launch_from<PH + 1>(p, stream);
}
#endif

extern "C" void kernel_launch(void* const* d_in, const int* in_sizes, int n_in, void* d_out, int out_size, void* d_ws, size_t ws_size,
                              hipStream_t stream) {
  Params p;
  memset(&p, 0, sizeof(p));
  const float** f = (const float**)&p;
  for (int i = 0; i < 29; i++) f[i] = (const float*)d_in[i];
  p.out = (float*)d_out;
  setup_ws(p, (unsigned char*)d_ws, (unsigned char*)d_out);
#if FUSED
  static int grid_blocks = 0;
  if (!grid_blocks) {
    int dev = 0, cus = 0, per_cu = 0;
    (void)hipGetDevice(&dev);
    (void)hipDeviceGetAttribute(&cus, hipDeviceAttributeMultiprocessorCount, dev);
    (void)hipOccupancyMaxActiveBlocksPerMultiprocessor(&per_cu, mega_kernel, 256, 0);
    if (per_cu > 2) per_cu = 2;
    grid_blocks = cus * per_cu;
  }
  void* args[] = {(void*)&p};
  hipError_t e = hipLaunchCooperativeKernel((void*)mega_kernel, dim3(grid_blocks), dim3(256), args, 0, stream);
  if (e != hipSuccess) fprintf(stderr, "cooperative launch failed: %s (grid %d)\n", hipGetErrorString(e), grid_blocks);
#else
  launch_from<0>(p, stream);
#endif
}
#endif
```

```cpp
#ifndef HOST_TEST
#include <hip/hip_runtime.h>
#include <hip/hip_cooperative_groups.h>
#include <cstdio>
#include <cstring>
namespace cg = cooperative_groups;
#define HD __host__ __device__ __forceinline__
#else
#include <cmath>
#include <cstdio>
#include <cstdlib>
#include <cstring>
#define HD inline
#endif

#ifndef FUSED
#define FUSED 1
#endif
#ifndef PROBE_DUP
#define PROBE_DUP 0
#endif

typedef unsigned short bf16;
typedef _Float16 f16;

#ifdef HOST_TEST
constexpr int D = HT_D, BATCH = HT_B, SEQ = HT_SEQ, CTX = HT_CTX;
#else
constexpr int D = 2048, BATCH = 4, SEQ = 2048, CTX = 256;
#endif
constexpr int ML = BATCH * SEQ;
constexpr int MC = BATCH * CTX;
constexpr int M = ML + MC;
constexpr int GW = 64, ROWS = SEQ / GW;
constexpr int D3 = 3 * D;
constexpr int EVEN_IN = 8448, ODD_IN = 7232;
constexpr int NMOD = BATCH + 1;
constexpr float NORM_EPS = 1e-6f;

struct Params {
  const float *x, *c, *ctx, *c_ctx, *ada_w, *ada_b, *norm_w, *e_w_in, *e_w_out, *na_rpb, *rw_mu, *rw_w0, *rw_w2, *rw_a0, *rw_a2,
      *rw_k_k, *rw_k_a, *rw_r_k, *rw_ln_w, *rw_ln_b, *o_w_in, *o_w_out, *mla_q_norm, *mla_w_uq, *mla_kv_norm, *mla_w_ukv, *hg_lb,
      *hg_norm_w, *final_norm_w;
  float* out;
  float* mod;
  bf16* H;
  bf16* YALL;
  float* XC1;
  bf16* QKV0;
  bf16* G0;
  bf16* U0;
  f16* Yd;
  bf16* LRb;
  float* LR;
  float* KN;
  f16 *R, *V, *KK;
  f16 *KD, *BB, *DL;
  bf16* CQKV;
  bf16 *HGQ, *HGI;
  bf16* HGF;
  bf16* G1;
  bf16 *CQN;
  bf16 *CKVN;
  bf16* KPE;
  bf16* Q;
  bf16* KV;
  f16* O1d;
  bf16 *Bt0, *BtOut0, *Bt1, *BtOut1, *Buq, *Bukv, *Btm;
  bf16 *X1b, *X2b;
  float* ROPE;
};

HD float bf2f(bf16 v) {
  union { unsigned u; float f; } x;
  x.u = ((unsigned)v) << 16;
  return x.f;
}
HD bf16 f2bf(float f) {
#if defined(__HIP_DEVICE_COMPILE__)
  return __builtin_bit_cast(unsigned short, (__bf16)f);
#else
  union { unsigned u; float f; } x;
  x.f = f;
  unsigned r = x.u + 0x7FFFu + ((x.u >> 16) & 1u);
  return (bf16)(r >> 16);
#endif
}
HD float sigmoidf_(float x) { return 1.0f / (1.0f + expf(-x)); }
HD float siluf_(float x) { return x / (1.0f + expf(-x)); }
HD int clampi(int v, int lo, int hi) { return v < lo ? lo : (v > hi ? hi : v); }
HD long kvrow(long m) {
  return m < ML ? (m / SEQ) * (SEQ + CTX) + m % SEQ : ((m - ML) / CTX) * (SEQ + CTX) + SEQ + (m - ML) % CTX;
}

#if defined(__HIP_DEVICE_COMPILE__)
#define UNIFORM(x) __builtin_amdgcn_readfirstlane(x)
#else
#define UNIFORM(x) (x)
#endif

HD void atomic_addf(float* p, float v) {
#if defined(__HIP_DEVICE_COMPILE__)
  atomicAdd(p, v);
#elif defined(HOST_TEST)
#pragma omp atomic
  *p += v;
#else
  *p += v;
#endif
}

constexpr long N_ADALN = 2L * D3;
HD void body_adaln(const Params& p, long gid) {
  int l = (int)(gid / D3), j = (int)(gid % D3);
  float acc[NMOD];
#pragma unroll
  for (int r = 0; r < NMOD; r++) acc[r] = 0.f;
  const float* w = p.ada_w + (long)l * D * D3 + j;
  for (int k = 0; k < D; k++) {
    float wv = w[(long)k * D3];
#pragma unroll
    for (int r = 0; r < NMOD; r++) {
      float cv = (r < BATCH) ? p.c[r * D + k] : p.c_ctx[k];
      acc[r] += siluf_(cv) * wv;
    }
  }
#pragma unroll
  for (int r = 0; r < NMOD; r++) p.mod[((long)l * NMOD + r) * D3 + j] = acc[r] + p.ada_b[l * D3 + j];
}

HD void body_normmod(const Params& p, int l, long m) {
  const float* src;
  int r;
  if (m < ML) {
    src = (l == 0 ? p.x : p.out) + m * D;
    r = (int)(m / SEQ);
  } else {
    src = (l == 0 ? p.ctx : p.XC1) + (m - ML) * D;
    r = BATCH;
  }
  float ss = 0.f;
  for (int k = 0; k < D; k++) ss += src[k] * src[k];
  float rstd = 1.0f / sqrtf(ss / D + NORM_EPS);
  const float* md = p.mod + ((long)l * NMOD + r) * D3;
  const float* nw = p.norm_w + l * D;
  for (int k = 0; k < D; k++) p.H[m * D + k] = f2bf(src[k] * rstd * nw[k] * (1.0f + md[D + k]) + md[k]);
}

struct EpiIn0 {
  const Params p_;
  HD void operator()(int m, int n, float v) const {
    if (n < 3072) p_.QKV0[(long)m * 3072 + n] = f2bf(v);
    else if (n < 6400) p_.U0[(long)m * 3328 + (n - 3072)] = f2bf(v);
    else p_.G0[(long)m * 2048 + (n - 6400)] = f2bf(siluf_(v));
  }
};
struct EpiOut0 {
  const Params p_;
  HD void operator()(int m, int n, float v) const {
    if (m < ML) {
      int b = m / SEQ;
      p_.out[(long)m * D + n] = p_.x[(long)m * D + n] + p_.mod[((long)0 * NMOD + b) * D3 + 2 * D + n] * v;
    } else {
      p_.XC1[(long)(m - ML) * D + n] = p_.ctx[(long)(m - ML) * D + n] + p_.mod[((long)0 * NMOD + BATCH) * D3 + 2 * D + n] * v;
    }
  }
};
struct EpiIn1 {
  const Params p_;
  HD void operator()(int m, int n, float v) const {
    if (n < 1088) p_.CQKV[(long)m * 1088 + n] = f2bf(v);
    else if (n < 2112) p_.HGQ[(long)m * 1024 + (n - 1088)] = f2bf(v);
    else if (n < 3136) p_.HGF[(long)m * 1024 + (n - 2112)] = f2bf(v);
    else if (n < 4160) p_.HGF[((long)M + m) * 1024 + (n - 3136)] = f2bf(v);
    else if (n < 5184) p_.HGI[(long)m * 1024 + (n - 4160)] = f2bf(v);
    else if (m < ML) p_.G1[(long)m * 2048 + (n - 5184)] = f2bf(siluf_(v));
  }
};
struct EpiQ {
  const Params p_;
  HD void operator()(int m, int n, float v) const { p_.Q[(long)m * 1536 + n] = f2bf(v); }
};
struct EpiKV {
  const Params p_;
  HD void operator()(int m, int n, float v) const { p_.KV[kvrow(m) * 2048 + n] = f2bf(v); }
};
struct EpiOut1 {
  const Params p_;
  HD void operator()(int m, int n, float v) const {
    int b = m / SEQ;
    p_.out[(long)m * D + n] += p_.mod[((long)1 * NMOD + b) * D3 + 2 * D + n] * v;
  }
};

HD float ushift(const Params& p, long m, int c) {
  bool first, last;
  if (m < ML) {
    int t = (int)(m % SEQ);
    first = (t == 0);
    last = (t == SEQ - 1);
  } else {
    int t = (int)((m - ML) % CTX);
    first = (t == 0);
    last = (t == CTX - 1);
  }
  float u = bf2f(p.U0[m * 3328 + c]);
  float pv = first ? 0.f : bf2f(p.U0[(m - 1) * 3328 + c]);
  float nx = last ? 0.f : bf2f(p.U0[(m + 1) * 3328 + c]);
  return u + p.rw_mu[c] * (pv - u) + p.rw_mu[3328 + c] * (nx - u);
}

constexpr long N_LR = (long)M * 256;
HD void body_rwkv_lr(const Params& p, long gid) {
  long m = gid / 256;
  int j = (int)(gid % 256);
  float v = ushift(p, m, 3072 + j);
  p.LR[gid] = (j < 128) ? tanhf(v) : v;
}
constexpr long N_KN = (long)M * 16;
HD void body_rwkv_kn(const Params& p, long gid) {
  long m = gid / 16;
  int h = (int)(gid % 16);
  float ss = 0.f;
  for (int i = 0; i < 64; i++) {
    int c = h * 64 + i;
    float k = ushift(p, m, 1024 + c) * p.rw_k_k[c];
    ss += k * k;
  }
  p.KN[gid] = 1.0f / fmaxf(sqrtf(ss), 1e-12f);
}
constexpr long N_TERMS = (long)M * 1024;
HD void body_rwkv_terms(const Params& p, long gid) {
  long m = gid / 1024;
  int c = (int)(gid % 1024);
  float r = ushift(p, m, c), k = ushift(p, m, 1024 + c), v = ushift(p, m, 2048 + c);
  float kk = k * p.rw_k_k[c] * p.KN[m * 16 + (c >> 6)];
  p.R[gid] = (f16)r;
  p.V[gid] = (f16)v;
  p.KK[gid] = (f16)(-kk);
  const float* lr = p.LR + m * 256;
#pragma unroll
  for (int d = 0; d < 2; d++) {
    float w = p.rw_w0[d * 1024 + c], a = p.rw_a0[d * 1024 + c];
    const float* w2 = p.rw_w2 + (long)d * 64 * 1024 + c;
    const float* a2 = p.rw_a2 + (long)d * 64 * 1024 + c;
    for (int j = 0; j < 64; j++) {
      w += lr[d * 64 + j] * w2[j * 1024];
      a += lr[128 + d * 64 + j] * a2[j * 1024];
    }
    float e = sigmoidf_(w) * 0.60653065971263342f;
    a = sigmoidf_(a);
    float kd = k * (1.0f + (a - 1.0f) * p.rw_k_a[c]);
    long o = (long)d * M * 1024 + gid;
    p.DL[o] = (f16)(expm1f(-e));
    p.KD[o] = (f16)kd;
    p.BB[o] = (f16)(kk * a);
  }
}

constexpr long N_NA = 4L * 8 * M;
HD void body_na(const Params& p, long gid) {
  long m = gid % M;
  int h = (int)((gid / M) % 8);
  int dc = (int)(gid / ((long)M * 8));
  const bf16* q = p.QKV0 + m * 3072 + h * 128;
  const float scale = 0.08838834764831845f;
  float o[32];
#pragma unroll
  for (int i = 0; i < 32; i++) o[i] = 0.f;
  float mx = -1e30f, l = 0.f;
  int b;
  int nloc = 0, r = 0, j = 0, r0 = 0, c0 = 0;
  if (m < ML) {
    b = (int)(m / SEQ);
    int t = (int)(m % SEQ);
    r = t / GW;
    j = t % GW;
    r0 = clampi(r - 4, 0, ROWS - 8);
    c0 = clampi(j - 8, 0, GW - 16);
    nloc = 128;
  } else {
    b = (int)((m - ML) / CTX);
  }
  for (int kidx = 0; kidx < nloc + CTX; kidx++) {
    long mk;
    float bias = 0.f;
    if (kidx < nloc) {
      int a = kidx >> 4, kx = kidx & 15;
      mk = (long)b * SEQ + (r0 + a) * GW + c0 + kx;
      bias = p.na_rpb[(h * 15 + (r0 + a - r + 7)) * 31 + (c0 + kx - j + 15)];
    } else {
      mk = ML + (long)b * CTX + (kidx - nloc);
    }
    const bf16* kp = p.QKV0 + mk * 3072 + 1024 + h * 128;
    float s = 0.f;
    for (int d = 0; d < 128; d++) s += bf2f(q[d]) * bf2f(kp[d]);
    s = s * scale + bias;
    if (s > mx) {
      float f = expf(mx - s);
      l *= f;
#pragma unroll
      for (int i = 0; i < 32; i++) o[i] *= f;
      mx = s;
    }
    float pe = expf(s - mx);
    l += pe;
    const bf16* vp = p.QKV0 + mk * 3072 + 2048 + h * 128 + dc * 32;
#pragma unroll
    for (int i = 0; i < 32; i++) o[i] += pe * bf2f(vp[i]);
  }
  float inv = 1.0f / l;
  int col = h * 128 + dc * 32;
#pragma unroll
  for (int i = 0; i < 32; i++) p.YALL[m * 2048 + col + i] = f2bf(o[i] * inv * bf2f(p.G0[m * 2048 + col + i]));
}

constexpr long N_RWSCAN = 2L * BATCH * 16 * 64;
HD void body_rwkv_scan(const Params& p, long gid) {
  int v = (int)(gid % 64);
  int h = UNIFORM((int)((gid / 64) % 16));
  int b = UNIFORM((int)((gid / 1024) % BATCH));
  int d = UNIFORM((int)(gid / (1024L * BATCH)));
  float S[64];
#pragma unroll
  for (int i = 0; i < 64; i++) S[i] = 0.f;
  for (int ph = 0; ph < 2; ph++) {
    int Tn = ph == 0 ? CTX : SEQ;
    long base = ph == 0 ? (ML + (long)b * CTX) : ((long)b * SEQ);
    for (int s = 0; s < Tn; s++) {
      int t = d == 0 ? s : Tn - 1 - s;
      long m = base + t;
      long o1 = m * 1024 + h * 64;
      long o2 = (long)d * M * 1024 + o1;
      float vv = (float)p.V[o1 + v];
      float sa = 0.f;
#pragma unroll
      for (int i = 0; i < 64; i++) sa += S[i] * (float)p.KK[o1 + i];
      float y = 0.f;
#pragma unroll
      for (int i = 0; i < 64; i++) {
        float sn = S[i] + S[i] * (float)p.DL[o2 + i] + sa * (float)p.BB[o2 + i] + vv * (float)p.KD[o2 + i];
        S[i] = sn;
        y += sn * (float)p.R[o1 + i];
      }
      p.Yd[o2 + v] = (f16)y;
    }
  }
}

constexpr long N_RWOUT = (long)M * 16;
HD void body_rwkv_out(const Params& p, long gid) {
  long m = gid / 16;
  int h = (int)(gid % 16);
  long o1 = m * 1024 + h * 64;
  const long o2 = (long)M * 1024 + o1;
  float mu = 0.f;
  for (int i = 0; i < 64; i++) mu += (float)p.Yd[o1 + i] + (float)p.Yd[o2 + i];
  mu *= (1.0f / 64);
  float var = 0.f, bonus = 0.f;
  for (int i = 0; i < 64; i++) {
    float dlt = (float)p.Yd[o1 + i] + (float)p.Yd[o2 + i] - mu;
    var += dlt * dlt;
    float kd = (float)p.KD[o1 + i] + (float)p.KD[o2 + i];
    bonus += (float)p.R[o1 + i] * kd * p.rw_r_k[h * 64 + i];
  }
  float rs = 1.0f / sqrtf(var * (1.0f / 64) + 64e-5f);
  for (int i = 0; i < 64; i++) {
    int c = h * 64 + i;
    float yn = ((float)p.Yd[o1 + i] + (float)p.Yd[o2 + i] - mu) * rs * p.rw_ln_w[c] + p.rw_ln_b[c] + bonus * (float)p.V[o1 + i];
    p.YALL[m * 2048 + 1024 + c] = f2bf(yn * bf2f(p.G0[m * 2048 + 1024 + c]));
  }
}

HD void rope_angle(int t, int i, float& cs, float& sn) {
  int f = i & 15;
  float pos = (float)((i < 16) ? (t / GW) : (t % GW));
  float inv = powf(10000.0f, -(float)f / 16.0f);
  float ang = pos * inv;
  cs = cosf(ang);
  sn = sinf(ang);
}
HD void body_mla_prep(const Params& p, long m) {
  const bf16* z = p.CQKV + m * 1088;
  if (m < ML) {
    float ss = 0.f;
    for (int k = 0; k < 512; k++) ss += bf2f(z[k]) * bf2f(z[k]);
    float rstd = 1.0f / sqrtf(ss / 512 + NORM_EPS);
    for (int k = 0; k < 512; k++) p.CQN[m * 512 + k] = f2bf(bf2f(z[k]) * rstd * p.mla_q_norm[k]);
  }
  {
    float ss = 0.f;
    for (int k = 0; k < 512; k++) ss += bf2f(z[512 + k]) * bf2f(z[512 + k]);
    float rstd = 1.0f / sqrtf(ss / 512 + NORM_EPS);
    for (int k = 0; k < 512; k++) p.CKVN[m * 512 + k] = f2bf(bf2f(z[512 + k]) * rstd * p.mla_kv_norm[k]);
  }
  for (int i = 0; i < 32; i++) {
    float x0 = bf2f(z[1024 + 2 * i]), x1 = bf2f(z[1024 + 2 * i + 1]);
    if (m < ML) {
      float cs, sn;
      rope_angle((int)(m % SEQ), i, cs, sn);
      float y0 = x0 * cs - x1 * sn, y1 = x0 * sn + x1 * cs;
      x0 = y0;
      x1 = y1;
    }
    p.KPE[kvrow(m) * 64 + 2 * i] = f2bf(x0);
    p.KPE[kvrow(m) * 64 + 2 * i + 1] = f2bf(x1);
  }
}
constexpr long N_ROPEQ = (long)ML * 8 * 32;
HD void body_rope_q(const Params& p, long gid) {
  int i = (int)(gid % 32);
  int h = (int)((gid / 32) % 8);
  long m = gid / 256;
  bf16* q = p.Q + m * 1536 + h * 192 + 128 + 2 * i;
  float cs, sn;
  rope_angle((int)(m % SEQ), i, cs, sn);
  float x0 = bf2f(q[0]), x1 = bf2f(q[1]);
  q[0] = f2bf(x0 * cs - x1 * sn);
  q[1] = f2bf(x0 * sn + x1 * cs);
}

constexpr long N_MLA = 4L * BATCH * 8 * SEQ;
HD void body_mla(const Params& p, long gid) {
  int t = (int)(gid % SEQ);
  int h = UNIFORM((int)((gid / SEQ) % 8));
  int b = UNIFORM((int)((gid / (8L * SEQ)) % BATCH));
  int dc = UNIFORM((int)(gid / (8L * SEQ * BATCH)));
  long m = (long)b * SEQ + t;
  const bf16* q = p.Q + m * 1536 + h * 192;
  const float scale = 0.07216878364870322f;
  float o[32];
#pragma unroll
  for (int i = 0; i < 32; i++) o[i] = 0.f;
  float mx = -1e30f, l = 0.f;
  for (int kidx = 0; kidx < SEQ + CTX; kidx++) {
    long mk = (long)b * (SEQ + CTX) + kidx;
    const bf16* kn = p.KV + mk * 2048 + h * 256;
    const bf16* kp = p.KPE + mk * 64;
    float s = 0.f;
    for (int d = 0; d < 128; d++) s += bf2f(q[d]) * bf2f(kn[d]);
    for (int d = 0; d < 64; d++) s += bf2f(q[128 + d]) * bf2f(kp[d]);
    s *= scale;
    if (s > mx) {
      float f = expf(mx - s);
      l *= f;
#pragma unroll
      for (int i = 0; i < 32; i++) o[i] *= f;
      mx = s;
    }
    float pe = expf(s - mx);
    l += pe;
    const bf16* vp = kn + 128 + dc * 32;
#pragma unroll
    for (int i = 0; i < 32; i++) o[i] += pe * bf2f(vp[i]);
  }
  float inv = 1.0f / l;
  int col = h * 128 + dc * 32;
#pragma unroll
  for (int i = 0; i < 32; i++) p.YALL[m * 2048 + col + i] = f2bf(o[i] * inv * bf2f(p.G1[m * 2048 + col + i]));
}

constexpr long N_HGSCAN = 2L * BATCH * 8 * 128;
HD void body_hg_scan(const Params& p, long gid) {
  int e = (int)(gid % 128);
  int h = UNIFORM((int)((gid / 128) % 8));
  int b = UNIFORM((int)((gid / 1024) % BATCH));
  int d = UNIFORM((int)(gid / (1024L * BATCH)));
  float S[128];
#pragma unroll
  for (int i = 0; i < 128; i++) S[i] = 0.f;
  for (int ph = 0; ph < 2; ph++) {
    int Tn = ph == 0 ? CTX : SEQ;
    long base = ph == 0 ? (ML + (long)b * CTX) : ((long)b * SEQ);
    for (int s = 0; s < Tn; s++) {
      int t = d == 0 ? s : Tn - 1 - s;
      long m = base + t;
      long o1 = m * 1024 + h * 128;
      const bf16* fp = p.HGF + (long)d * M * 1024 + o1;
      float vv = bf2f(p.HGI[o1 + e]);
      float o = 0.f;
#pragma unroll
      for (int i = 0; i < 128; i++) {
        float h0 = p.hg_lb[h * 128 + i], h1 = p.hg_lb[1024 + h * 128 + i];
        float lb = 1.0f / (1.0f + expf(h0 - h1));
        float sg = sigmoidf_(bf2f(fp[i]));
        float f = lb + (1.0f - lb) * sg;
        float kk = (1.0f - lb) * (1.0f - sg);
        float sn = f * S[i] + kk * vv;
        S[i] = sn;
        o += bf2f(p.HGQ[o1 + i]) * sn;
      }
      if (ph == 1) p.O1d[(long)d * ML * 1024 + o1 + e] = (f16)o;
    }
  }
}
constexpr long N_HGOUT = (long)ML * 8;
HD void body_hg_out(const Params& p, long gid) {
  long m = gid / 8;
  int h = (int)(gid % 8);
  long o1 = m * 1024 + h * 128;
  const long o2 = (long)ML * 1024 + o1;
  float ss = 0.f;
  for (int i = 0; i < 128; i++) { float o = (float)p.O1d[o1 + i] + (float)p.O1d[o2 + i]; ss += o * o; }
  float rstd = 1.0f / sqrtf(ss / 128 + NORM_EPS);
  for (int i = 0; i < 128; i++) {
    int c = 1024 + h * 128 + i;
    float o = (float)p.O1d[o1 + i] + (float)p.O1d[o2 + i];
    p.YALL[m * 2048 + c] = f2bf(o * rstd * p.hg_norm_w[i] * bf2f(p.G1[m * 2048 + c]));
  }
}

HD void body_final(const Params& p, long m) {
  float* x = p.out + m * D;
  float ss = 0.f;
  for (int k = 0; k < D; k++) ss += x[k] * x[k];
  float rstd = 1.0f / sqrtf(ss / D + NORM_EPS);
  for (int k = 0; k < D; k++) x[k] = x[k] * rstd * p.final_norm_w[k];
}


constexpr int HG_C = 32, HG_LDQ = 136, HG_LDT = 40;
constexpr int HG_OFF_QI = 0, HG_OFF_KI = HG_OFF_QI + HG_C * HG_LDQ * 2, HG_OFF_KET = HG_OFF_KI + HG_C * HG_LDQ * 2, HG_OFF_VT = HG_OFF_KET + 128 * HG_LDT * 2,
              HG_OFF_DEC = HG_OFF_VT + 128 * HG_LDT * 2, HG_OFF_GS = HG_OFF_DEC + 512, HG_LDS = HG_OFF_GS + 2048;
HD long seq_row(int d, int b, int g) {
  if (g < CTX) return ML + (long)b * CTX + (d ? CTX - 1 - g : g);
  g -= CTX;
  return (long)b * SEQ + (d ? SEQ - 1 - g : g);
}
HD int kperm(int g, int j) { return 16 * (j >> 2) + 4 * g + (j & 3); }


constexpr int RC = 16, RC_LD = 72, RC_LDJ = 40;
constexpr int RC_AT = 0, RC_RT = RC_AT + 16 * RC_LD * 2, RC_BT = RC_RT + 16 * RC_LD * 2, RC_KT = RC_BT + 16 * RC_LD * 2, RC_KH = RC_KT + 16 * RC_LD * 2,
              RC_VT = RC_KH + 64 * RC_LDJ * 2, RC_BH = RC_VT + 64 * RC_LDJ * 2, RC_PC = RC_BH + 64 * 16 * 2, RC_IMG = RC_PC + 256;
constexpr int RC_NKT = 0, RC_MKT = RC_NKT + 16 * RC_LDJ * 2, RC_TT = RC_MKT + 16 * RC_LDJ * 2, RC_MBT = RC_TT + 16 * 16 * 2, RC_MAT = RC_MBT + 16 * 16 * 2;
constexpr int RC_MAT0 = 3 * RC_IMG, RC_NBF = RC_MAT0 + 2 * RC_MAT, RC_GP = RC_NBF + 16 * 20 * 4, RC_LDS = RC_GP + 8 * 64 * 4;

HD size_t al256(size_t x) { return (x + 255) & ~(size_t)255; }
constexpr int N1PAD = 7424;
inline size_t setup_ws(Params& p, unsigned char* ws, unsigned char* outbuf) {
  size_t o = 0;
  auto take = [&](size_t bytes) {
    unsigned char* r = ws + o;
    o += al256(bytes);
    return r;
  };
  p.mod = (float*)take(sizeof(float) * 2 * NMOD * D3);
  p.ROPE = (float*)take(4L * SEQ * 64);
  p.H = (bf16*)take(2L * M * (D > 2048 ? D : 2048));
  p.YALL = p.H;
  take(16384);
  p.XC1 = (float*)take(4L * MC * D);
  p.BtOut0 = (bf16*)take(2L * D * 2048);
  p.Btm = (bf16*)take(2L * 4096 * 256);
  size_t mark = o;
  p.QKV0 = (bf16*)take(2L * M * 3072);
  p.G0 = (bf16*)take(2L * M * 2048);
  p.LR = (float*)take(4L * M * 256);
  p.LRb = (bf16*)p.LR;
  p.KN = (float*)take(4L * M * 16);
  size_t terms0 = o;
  p.R = (f16*)take(2L * M * 1024);
  p.V = (f16*)take(2L * M * 1024);
  p.KK = (f16*)take(2L * M * 1024);
  p.KD = (f16*)take(2L * 2 * M * 1024);
  p.BB = (f16*)take(2L * 2 * M * 1024);
  p.DL = (f16*)take(2L * 2 * M * 1024);
  size_t end0 = o;
  p.Bt0 = (bf16*)(ws + terms0);
  p.U0 = (bf16*)outbuf;
  p.Yd = (f16*)outbuf;
  o = mark;
  p.CQKV = (bf16*)take(2L * M * 1088);
  p.HGQ = (bf16*)take(2L * M * 1024);
  p.X2b = p.CQKV;
  p.X1b = (bf16*)outbuf;
  p.HGI = (bf16*)take(2L * M * 1024);
  p.HGF = (bf16*)take(2L * 2 * M * 1024);
  p.G1 = (bf16*)take(2L * ML * 2048);
  p.CQN = (bf16*)take(2L * ML * 512);
  p.CKVN = (bf16*)take(2L * M * 512);
  p.KPE = (bf16*)take(2L * M * 64);
  p.Q = (bf16*)take(2L * ML * 1536);
  p.KV = (bf16*)take(2L * M * 2048);
  p.O1d = (f16*)take(2L * 2 * ML * 1024);
  p.Bt1 = (bf16*)take(2L * N1PAD * D);
  p.BtOut1 = (bf16*)take(2L * D * 2048);
  p.Buq = (bf16*)take(2L * 1536 * 512);
  p.Bukv = (bf16*)take(2L * 2048 * 512);
  size_t end1 = o;
  return end0 > end1 ? end0 : end1;
}

#ifndef HOST_TEST
#define LAS __attribute__((address_space(3)))
__device__ __forceinline__ int fresh_tid(int wave_s) {
  int lane;
  asm volatile("v_mbcnt_lo_u32_b32 %0, -1, 0\n\tv_mbcnt_hi_u32_b32 %0, -1, %0" : "=v"(lane));
  return wave_s * 64 + lane;
}
#define WG_BAR_LDS() do { asm volatile("s_waitcnt lgkmcnt(0)" ::: "memory"); __builtin_amdgcn_s_barrier(); asm volatile("" ::: "memory"); } while (0)
constexpr int NT = 512;
constexpr int LDS_BYTES = 152 * 1024;

namespace pg8 {
#define PG8_LAS __attribute__((address_space(3)))
typedef unsigned short bf16_t;
typedef short bf16x8 __attribute__((ext_vector_type(8)));
typedef float f32x4 __attribute__((ext_vector_type(4)));
typedef unsigned u32x4 __attribute__((ext_vector_type(4)));
constexpr int BM = 256, BK = 64, HALF = 128, HTB = HALF * BK * 2  , STAGE_BYTES = 8 * HTB, NXCD = 8, WGM = 8;

__host__ __device__ __forceinline__ int lds_byte(int r, int c) { const int st = (r >> 4) * 2 + (c >> 5), rr = r & 15, cc = c & 31, ob = rr * 64 + cc * 2; return st * 1024 + (ob ^ (((ob >> 9) & 1) << 5)); }
__host__ __device__ __forceinline__ void stage_rc(int b, int& R, int& C) { const int st = b / 1024, sb = b % 1024, swz = sb ^ (((sb >> 9) & 1) << 5); R = (st >> 1) * 16 + swz / 64; C = (st & 1) * 32 + (swz % 64) / 2; }
__host__ __device__ __forceinline__ int perm32(int rho) { const int n = rho >> 4, i = rho & 15; return 8 * (i >> 2) + 4 * n + (i & 3); }

struct Unit { int pm, pn, kind = 0; };
struct Gemm { const bf16_t* A; const bf16_t* Bt; int M, N, K; const bf16_t* A2 = nullptr; const bf16_t* Bt2 = nullptr; };

struct StaticOrder {
    int nM, nN, nwg, G, c;
    __host__ __device__ void init(int M, int N, int G_, int c_) { nM = M / BM; nN = N / BM; nwg = nM * nN; G = G_; c = c_; }
    __host__ __device__ bool next(int i, Unit& u) const {
        const long L = (long)i * G + c; if (L >= nwg) return false;
        map((int)L, u); return true;
    }
    __host__ __device__ void map(int L, Unit& u) const {
        int wgid = L; { const int q = nwg / NXCD, r = nwg % NXCD, xcd = wgid % NXCD, off = wgid / NXCD; wgid = (xcd < r ? xcd * (q + 1) : r * (q + 1) + (xcd - r) * q) + off; }
        const int nig = WGM * nN, gid = wgid / nig, fm = gid * WGM, gsz = (nM - fm) < WGM ? (nM - fm) : WGM;
        u.pm = fm + ((wgid % nig) % gsz); u.pn = (wgid % nig) / gsz;
    }
    __device__ __forceinline__ void a_ready(const Unit&) const {}
    __device__ __forceinline__ void done(const Unit&) const {}
};
__device__ __forceinline__ unsigned cvt_pk_bf16(float lo, float hi) { unsigned r; asm volatile("v_cvt_pk_bf16_f32 %0, %1, %2" : "=v"(r) : "v"(lo), "v"(hi)); return r; }
template <class Epi, class Sched, bool STAMP = false>
__device__ __forceinline__ void gemm_phase(PG8_LAS unsigned char* lds, const Gemm g, const Sched& S, const Epi& E, const int tid) {
    const int wid = __builtin_amdgcn_readfirstlane(tid >> 6), lane = tid & 63, wr = wid >> 2, wc = wid & 3, fr = lane & 15, fq = lane >> 4;
    const int K = g.K, nt = K / BK;
    unsigned voffA[2], voffB[2];
#pragma unroll
    for (int i = 0; i < 2; ++i) { int R, C; stage_rc(tid * 16 + i * 8192, R, C); const int Rb = Epi::PERM ? ((R & ~31) + perm32(R & 31)) : R;
        voffA[i] = (unsigned)(R * K + C) * 2u; voffB[i] = (unsigned)(Rb * K + C) * 2u; }
    const size_t kstep = (size_t)(BK * 2);
    const size_t hstep = (size_t)HALF * K * 2;
    const size_t tstep = 2 * hstep;
    const unsigned ldsw = (unsigned)wid * 1024u;
    const int aoff = lds_byte(wr * 64 + fr, fq * 8), boff = lds_byte(wc * 32 + fr, fq * 8);
#define PG8_SA(b, h) (((b) * 2 + (h)) * HTB)
#define PG8_SB(b, h) ((4 + (b) * 2 + (h)) * HTB)
#define PG8_STAGE(bufoff, gbase, voff) do { _Pragma("unroll") for (int _i = 0; _i < 2; ++_i) \
        __builtin_amdgcn_global_load_lds((const unsigned*)((const char*)(gbase) + (voff)[_i]), (PG8_LAS unsigned*)(lds + (bufoff) + ldsw + _i * 8192), 16, 0, 0); } while (0)
#define PG8_LDA(dst, b, h) do { _Pragma("unroll") for (int m = 0; m < 4; ++m) _Pragma("unroll") for (int k = 0; k < 2; ++k) dst[m][k] = *(const PG8_LAS bf16x8*)(lds + PG8_SA(b, h) + aoff + m * 2048 + k * 1024); } while (0)
#define PG8_LDB(dst, b, h) do { _Pragma("unroll") for (int n = 0; n < 2; ++n) _Pragma("unroll") for (int k = 0; k < 2; ++k) dst[n][k] = *(const PG8_LAS bf16x8*)(lds + PG8_SB(b, h) + boff + n * 2048 + k * 1024); } while (0)
#define PG8_MMA(ai, bj, At, Bt) do { __builtin_amdgcn_s_setprio(1); _Pragma("unroll") for (int m = 0; m < 4; ++m) _Pragma("unroll") for (int n = 0; n < 2; ++n) _Pragma("unroll") for (int k = 0; k < 2; ++k) \
        acc[ai][bj][m][n] = __builtin_amdgcn_mfma_f32_16x16x32_bf16(Bt[n][k], At[m][k], acc[ai][bj][m][n], 0, 0, 0); __builtin_amdgcn_s_setprio(0); } while (0)
#define PG8_WAIT_V(n) asm volatile("s_waitcnt vmcnt(" #n ")" ::: "memory")
#define PG8_WAIT_L(n) asm volatile("s_waitcnt lgkmcnt(" #n ")" ::: "memory")
#define PG8_BAR __builtin_amdgcn_s_barrier()
#define PG8_SCHED __builtin_amdgcn_sched_barrier(0)
    Unit cur, nxt; int ui = 0;
    if (!S.next(0, cur)) return;
    f32x4 acc[2][2][4][2];
#pragma unroll
    for (int a = 0; a < 2; ++a)
#pragma unroll
        for (int b = 0; b < 2; ++b)
#pragma unroll
            for (int m = 0; m < 4; ++m)
#pragma unroll
                for (int n = 0; n < 2; ++n) acc[a][b][m][n] = (f32x4){0.f, 0.f, 0.f, 0.f};
    bf16x8 At[4][2], B0[2][2], B1[2][2];
    const char* cA = (const char*)(cur.kind ? g.A2 : g.A) + (size_t)cur.pm * tstep; const char* cB = (const char*)(cur.kind ? g.Bt2 : g.Bt) + (size_t)cur.pn * tstep;
    S.a_ready(cur);
    PG8_STAGE(PG8_SB(0, 0), cB, voffB); PG8_STAGE(PG8_SA(0, 0), cA, voffA); PG8_STAGE(PG8_SB(0, 1), cB + hstep, voffB); PG8_STAGE(PG8_SA(0, 1), cA + hstep, voffA);
    if (wr == 1) PG8_BAR;
    PG8_WAIT_V(4); PG8_BAR;
    PG8_STAGE(PG8_SB(1, 0), cB + kstep, voffB); PG8_STAGE(PG8_SA(1, 0), cA + kstep, voffA); PG8_STAGE(PG8_SB(1, 1), cB + hstep + kstep, voffB);
    PG8_WAIT_V(6); PG8_BAR;
    for (;;) {
        const bool has_next = S.next(ui + 1, nxt);
        const char* nA = has_next ? (const char*)(nxt.kind ? g.A2 : g.A) + (size_t)nxt.pm * tstep : cA; const char* nB = has_next ? (const char*)(nxt.kind ? g.Bt2 : g.Bt) + (size_t)nxt.pn * tstep : cB;
        for (int t = 0; t < nt; t += 2) {
            const bool last = (t == nt - 2);
            const char* a1 = cA + (size_t)(t + 1) * kstep;
            const char* a2 = last ? nA : cA + (size_t)(t + 2) * kstep; const char* b2 = last ? nB : cB + (size_t)(t + 2) * kstep;
            const char* a3 = a2 + kstep; const char* b3 = b2 + kstep;
            if (last && has_next) S.a_ready(nxt);
            PG8_LDB(B0, 0, 0); PG8_SCHED; PG8_LDA(At, 0, 0); PG8_STAGE(PG8_SA(1, 1), a1 + hstep, voffA);
            PG8_WAIT_L(8); PG8_BAR; PG8_WAIT_L(0); PG8_MMA(0, 0, At, B0); PG8_BAR; PG8_SCHED;
            PG8_LDB(B1, 0, 1); PG8_STAGE(PG8_SB(0, 0), b2, voffB);
            PG8_BAR; PG8_WAIT_L(0); PG8_MMA(0, 1, At, B1); PG8_BAR;
            PG8_LDA(At, 0, 1); PG8_STAGE(PG8_SA(0, 0), a2, voffA);
            PG8_BAR; PG8_WAIT_L(0); PG8_MMA(1, 0, At, B0); PG8_BAR; PG8_SCHED;
            PG8_STAGE(PG8_SB(0, 1), b2 + hstep, voffB);
            PG8_WAIT_V(6); PG8_BAR; PG8_MMA(1, 1, At, B1); PG8_BAR;
            PG8_LDB(B0, 1, 0); PG8_SCHED; PG8_LDA(At, 1, 0); PG8_STAGE(PG8_SA(0, 1), a2 + hstep, voffA);
            PG8_WAIT_L(8); PG8_BAR; PG8_WAIT_L(0); PG8_MMA(0, 0, At, B0); PG8_BAR; PG8_SCHED;
            PG8_LDB(B1, 1, 1); PG8_STAGE(PG8_SB(1, 0), b3, voffB);
            PG8_BAR; PG8_WAIT_L(0); PG8_MMA(0, 1, At, B1); PG8_BAR;
            PG8_LDA(At, 1, 1); PG8_STAGE(PG8_SA(1, 0), a3, voffA);
            PG8_BAR; PG8_WAIT_L(0); PG8_MMA(1, 0, At, B0); PG8_BAR; PG8_SCHED;
            PG8_STAGE(PG8_SB(1, 1), b3 + hstep, voffB);
            PG8_WAIT_V(6); PG8_BAR; PG8_MMA(1, 1, At, B1); PG8_BAR;
        }
        if constexpr (!Epi::AFTER_DRAIN) { E(acc, cur, wr, wc, fr, fq); S.done(cur); }
        else if (has_next) { E(acc, cur, wr, wc, fr, fq); S.done(cur); }
        if (!has_next) break;
#pragma unroll
        for (int a = 0; a < 2; ++a)
#pragma unroll
            for (int b = 0; b < 2; ++b)
#pragma unroll
                for (int m = 0; m < 4; ++m)
#pragma unroll
                    for (int n = 0; n < 2; ++n) acc[a][b][m][n] = (f32x4){0.f, 0.f, 0.f, 0.f};
        cur = nxt; cA = nA; cB = nB; ++ui;
    }
    PG8_WAIT_V(0);
    if (wr == 0) PG8_BAR;
    PG8_BAR;
    if constexpr (Epi::AFTER_DRAIN) { E.fused(acc, cur, wr, wc, fr, fq, lds, wid, lane); S.done(cur); }
#undef PG8_SA
#undef PG8_SB
#undef PG8_STAGE
#undef PG8_LDA
#undef PG8_LDB
#undef PG8_MMA
#undef PG8_WAIT_V
#undef PG8_WAIT_L
#undef PG8_BAR
#undef PG8_SCHED
}
}

using pg8::f32x4;
using pg8::u32x4;
__device__ __forceinline__ float silu_fast(float x) { return x * __builtin_amdgcn_rcpf(1.0f + __expf(-x)); }
template <bool ACT>
__device__ __forceinline__ u32x4 pack8(f32x4 v0, f32x4 v1) {
  if (ACT) {
#pragma unroll
    for (int j = 0; j < 4; j++) { v0[j] = silu_fast(v0[j]); v1[j] = silu_fast(v1[j]); }
  }
  u32x4 w;
  w.x = pg8::cvt_pk_bf16(v0[0], v0[1]); w.y = pg8::cvt_pk_bf16(v0[2], v0[3]);
  w.z = pg8::cvt_pk_bf16(v1[0], v1[1]); w.w = pg8::cvt_pk_bf16(v1[2], v1[3]);
  return w;
}
struct GEpiIn0 {
  static constexpr bool PERM = true, AFTER_DRAIN = false;
  bf16 *QKV0, *U0, *G0;
  __device__ __forceinline__ void operator()(const f32x4 (&acc)[2][2][4][2], const pg8::Unit& u, int wr, int wc, int fr, int fq) const {
    const int colt = u.pn * 256;
    bf16* base; int ld, cb; bool act = false;
    if (colt < 3072) { base = QKV0; ld = 3072; cb = colt; }
    else if (colt < 6400) { base = U0; ld = 3328; cb = colt - 3072; }
    else { base = G0; ld = 2048; cb = colt - 6400; act = true; }
    const int row0 = u.pm * 256 + wr * 64 + fr, col0 = cb + wc * 32 + 8 * fq;
#pragma unroll
    for (int ai = 0; ai < 2; ++ai)
#pragma unroll
      for (int m = 0; m < 4; ++m) {
        bf16* rowp = base + (size_t)(row0 + ai * 128 + m * 16) * ld + col0;
#pragma unroll
        for (int bj = 0; bj < 2; ++bj)
          *(u32x4*)(rowp + bj * 128) = act ? pack8<true>(acc[ai][bj][m][0], acc[ai][bj][m][1]) : pack8<false>(acc[ai][bj][m][0], acc[ai][bj][m][1]);
      }
  }
};
struct GEpiIn1 {
  static constexpr bool PERM = true, AFTER_DRAIN = false;
  bf16 *CQKV, *HGQ, *HGF, *HGI, *G1;
  const float* hg_lb;
  __device__ __forceinline__ void operator()(const f32x4 (&acc)[2][2][4][2], const pg8::Unit& u, int wr, int wc, int fr, int fq) const {
    const int colt = u.pn * 256;
    if (colt >= 2048 && colt < 4096) {
      bf16* base = HGF + (size_t)(colt >= 3072) * M * 1024; const int cb = colt & 1023;
      const int row0 = u.pm * 256 + wr * 64 + fr;
#pragma unroll
      for (int bj = 0; bj < 2; ++bj) {
        const int c = cb + bj * 128 + wc * 32 + 8 * fq;
        f32x4 oml[2];
#pragma unroll
        for (int n = 0; n < 2; ++n) {
          const f32x4 h0 = *(const f32x4*)(hg_lb + c + 4 * n), h1 = *(const f32x4*)(hg_lb + 1024 + c + 4 * n);
#pragma unroll
          for (int j = 0; j < 4; ++j) oml[n][j] = __builtin_amdgcn_rcpf(1.0f + __expf(h1[j] - h0[j]));
        }
#pragma unroll
        for (int ai = 0; ai < 2; ++ai)
#pragma unroll
          for (int m = 0; m < 4; ++m) {
            f32x4 o[2];
#pragma unroll
            for (int n = 0; n < 2; ++n)
#pragma unroll
              for (int j = 0; j < 4; ++j) o[n][j] = oml[n][j] * __builtin_amdgcn_rcpf(1.0f + __expf(acc[ai][bj][m][n][j]));
            *(u32x4*)(base + (size_t)(row0 + ai * 128 + m * 16) * 1024 + c) = pack8<false>(o[0], o[1]);
          }
      }
      return;
    }
    bf16* base; int ld, cb; bool act = false; int climit = 256;
    if (colt < 1024) { base = CQKV; ld = 1088; cb = colt; }
    else if (colt < 2048) { base = HGQ; ld = 1024; cb = colt - 1024; }
    else if (colt < 3072) { base = HGF; ld = 1024; cb = colt - 2048; }
    else if (colt < 4096) { base = HGF + (size_t)M * 1024; ld = 1024; cb = colt - 3072; }
    else if (colt < 5120) { base = HGI; ld = 1024; cb = colt - 4096; }
    else if (colt < 7168) { base = G1; ld = 2048; cb = colt - 5120; act = true; if (u.pm * 256 >= ML) return; }
    else { base = CQKV; ld = 1088; cb = 1024; climit = 64; }
    const int row0 = u.pm * 256 + wr * 64 + fr, cl = wc * 32 + 8 * fq;
#pragma unroll
    for (int ai = 0; ai < 2; ++ai)
#pragma unroll
      for (int m = 0; m < 4; ++m) {
        bf16* rowp = base + (size_t)(row0 + ai * 128 + m * 16) * ld + cb + cl;
#pragma unroll
        for (int bj = 0; bj < 2; ++bj)
          if (cl + bj * 128 < climit)
            *(u32x4*)(rowp + bj * 128) = act ? pack8<true>(acc[ai][bj][m][0], acc[ai][bj][m][1]) : pack8<false>(acc[ai][bj][m][0], acc[ai][bj][m][1]);
      }
  }
};
template <int LAYER>
struct GEpiOut {
  static constexpr bool PERM = true, AFTER_DRAIN = false;
  const float *x, *ctx, *mod;
  float* XC1; bf16 *X1b, *X2b;
  __device__ __forceinline__ void operator()(const f32x4 (&acc)[2][2][4][2], const pg8::Unit& u, int wr, int wc, int fr, int fq) const {
    const int rowt = u.pm * 256;
    const bool lat = rowt < ML;
    const float* gate = mod + ((size_t)LAYER * NMOD + (lat ? rowt / SEQ : BATCH)) * D3 + 2 * D;
    const int rbase = lat ? rowt : rowt - ML;
    const float* src; if (lat) src = x; else src = ctx;
    const int col0 = u.pn * 256 + wc * 32 + 8 * fq;
    f32x4 g[2][2];
#pragma unroll
    for (int bj = 0; bj < 2; ++bj)
#pragma unroll
      for (int n = 0; n < 2; ++n) g[bj][n] = *(const f32x4*)(gate + col0 + bj * 128 + n * 4);
#pragma unroll
    for (int ai = 0; ai < 2; ++ai)
#pragma unroll
      for (int m = 0; m < 4; ++m) {
        const size_t off = (size_t)(rbase + wr * 64 + fr + ai * 128 + m * 16) * D + col0;
#pragma unroll
        for (int bj = 0; bj < 2; ++bj) {
          f32x4 s0, s1;
          if (LAYER == 0 || !lat) {
            s0 = *(const f32x4*)(src + off + bj * 128); s1 = *(const f32x4*)(src + off + bj * 128 + 4);
          } else {
            const u32x4 w = *(const u32x4*)(X1b + off + bj * 128);
            s0 = (f32x4){__uint_as_float(w.x << 16), __uint_as_float(w.x & 0xffff0000u), __uint_as_float(w.y << 16), __uint_as_float(w.y & 0xffff0000u)};
            s1 = (f32x4){__uint_as_float(w.z << 16), __uint_as_float(w.z & 0xffff0000u), __uint_as_float(w.w << 16), __uint_as_float(w.w & 0xffff0000u)};
          }
          const f32x4 o0 = s0 + g[bj][0] * acc[ai][bj][m][0], o1 = s1 + g[bj][1] * acc[ai][bj][m][1];
          if (lat) *(u32x4*)((LAYER == 0 ? X1b : X2b) + off + bj * 128) = pack8<false>(o0, o1);
          else { *(f32x4*)(XC1 + off + bj * 128) = o0; *(f32x4*)(XC1 + off + bj * 128 + 4) = o1; }
        }
        if (m & 1) asm volatile("" ::: "memory");
      }
  }
};
struct GEpiQ {
  static constexpr bool PERM = true, AFTER_DRAIN = false;
  bf16* Q; const float* ROPE;
  __device__ __forceinline__ void operator()(const f32x4 (&acc)[2][2][4][2], const pg8::Unit& u, int wr, int wc, int fr, int fq) const {
    const int row0 = u.pm * 256 + wr * 64 + fr;
#pragma unroll
    for (int bj = 0; bj < 2; ++bj) {
      const int c0 = u.pn * 256 + bj * 128 + wc * 32 + 8 * fq;
      const int off = c0 % 192;
      const bool rope = off >= 128;
      const int pi = (off - 128) >> 1;
#pragma unroll
      for (int ai = 0; ai < 2; ++ai)
#pragma unroll
        for (int m = 0; m < 4; ++m) {
          const int row = row0 + ai * 128 + m * 16;
          f32x4 v0 = acc[ai][bj][m][0], v1 = acc[ai][bj][m][1];
          if (rope) {
            const f32x4* rt = (const f32x4*)(ROPE + ((size_t)(row % SEQ) * 32 + pi) * 2);
            const f32x4 cs0 = rt[0], cs1 = rt[1];
            f32x4 w0, w1;
            w0[0] = v0[0] * cs0[0] - v0[1] * cs0[1]; w0[1] = v0[0] * cs0[1] + v0[1] * cs0[0];
            w0[2] = v0[2] * cs0[2] - v0[3] * cs0[3]; w0[3] = v0[2] * cs0[3] + v0[3] * cs0[2];
            w1[0] = v1[0] * cs1[0] - v1[1] * cs1[1]; w1[1] = v1[0] * cs1[1] + v1[1] * cs1[0];
            w1[2] = v1[2] * cs1[2] - v1[3] * cs1[3]; w1[3] = v1[2] * cs1[3] + v1[3] * cs1[2];
            v0 = w0; v1 = w1;
          }
          *(u32x4*)(Q + (size_t)row * 1536 + c0) = pack8<false>(v0, v1);
        }
    }
  }
};
struct GEpiKV {
  static constexpr bool PERM = true, AFTER_DRAIN = false;
  bf16* KV;
  __device__ __forceinline__ void operator()(const f32x4 (&acc)[2][2][4][2], const pg8::Unit& u, int wr, int wc, int fr, int fq) const {
    const int row0 = u.pm * 256 + wr * 64 + fr, col0 = u.pn * 256 + wc * 32 + 8 * fq;
#pragma unroll
    for (int ai = 0; ai < 2; ++ai)
#pragma unroll
      for (int m = 0; m < 4; ++m) {
        bf16* rowp = KV + (size_t)kvrow(row0 + ai * 128 + m * 16) * 2048 + col0;
#pragma unroll
        for (int bj = 0; bj < 2; ++bj) *(u32x4*)(rowp + bj * 128) = pack8<false>(acc[ai][bj][m][0], acc[ai][bj][m][1]);
      }
  }
};

struct UpOrder {
  pg8::StaticOrder sq, sk; int G, c;
  __device__ void init(int G_, int c_) { sq.init(ML, 1536, G_, c_); sk.init(M, 2048, G_, c_); G = G_; c = c_; }
  __device__ bool next(int i, pg8::Unit& u) const {
    const long L = (long)i * G + c;
    constexpr int NQ = (ML / 256) * 6, NK = (M / 256) * 8;
    if (L >= NQ + NK) return false;
    if (L < NQ) { sq.map((int)L, u); return true; }
    sk.map((int)(L - NQ), u); u.pm += ML / 256; u.pn += 6;
    return true;
  }
  __device__ __forceinline__ void a_ready(const pg8::Unit&) const {}
  __device__ __forceinline__ void done(const pg8::Unit&) const {}
};
struct GEpiUp {
  static constexpr bool PERM = true, AFTER_DRAIN = false;
  GEpiQ q; GEpiKV kv;
  __device__ __forceinline__ void operator()(const f32x4 (&acc)[2][2][4][2], const pg8::Unit& u, int wr, int wc, int fr, int fq) const {
    if (u.pn < 6) q(acc, u, wr, wc, fr, fq);
    else { pg8::Unit v; v.pm = u.pm - ML / 256; v.pn = u.pn - 6; kv(acc, v, wr, wc, fr, fq); }
  }
};
struct In1Order {
  pg8::StaticOrder so; int G, c;
  __device__ void init(int G_, int c_) { so.init(ML, N1PAD, G_, c_); G = G_; c = c_; }
  __device__ bool next(int i, pg8::Unit& u) const {
    const long L = (long)i * G + c;
    constexpr int NLAT = (ML / 256) * (N1PAD / 256), NCTX = (MC / 256) * 19;
    if (L >= NLAT + NCTX) return false;
    if (L < NLAT) { so.map((int)L, u); return true; }
    const int r = (int)(L - NLAT);
    u.pm = ML / 256 + r % (MC / 256);
    const int idx = r / (MC / 256);
    u.pn = idx < 18 ? 2 + idx : 28;
    return true;
  }
  __device__ __forceinline__ void a_ready(const pg8::Unit&) const {}
  __device__ __forceinline__ void done(const pg8::Unit&) const {}
};

struct In1OrderN {
  pg8::StaticOrder so; int G, c;
  __device__ void init(int G_, int c_) { so.init(ML, 13 * 256, G_, c_); G = G_; c = c_; }
  __device__ bool next(int i, pg8::Unit& u) const {
    const long L = (long)i * G + c;
    constexpr int NLAT = (ML / 256) * 13, NCTX = (MC / 256) * 3;
    if (L >= NLAT + NCTX) return false;
    if (L < NLAT) { so.map((int)L, u); u.pn = u.pn < 4 ? u.pn : u.pn + 16; return true; }
    const int r = (int)(L - NLAT);
    u.pm = ML / 256 + r % (MC / 256);
    const int idx = r / (MC / 256);
    u.pn = idx < 2 ? 2 + idx : 28;
    return true;
  }
  __device__ __forceinline__ void a_ready(const pg8::Unit&) const {}
  __device__ __forceinline__ void done(const pg8::Unit&) const {}
};
struct In1OrderAll {
  pg8::StaticOrder st; In1OrderN sn; int G, c;
  __device__ void init(int G_, int c_) { st.init(4096, M, G_, c_); sn.init(G_, c_); G = G_; c = c_; }
  __device__ bool next(int i, pg8::Unit& u) const {
    const long L = (long)i * G + c;
    constexpr int NT_ = 16 * (M / 256);
    if (L < NT_) { st.map((int)L, u); u.kind = 1; return true; }
    const long Ln = L - NT_;
    constexpr int NLAT = (ML / 256) * 13, NCTX = (MC / 256) * 3;
    if (Ln >= NLAT + NCTX) return false;
    u.kind = 0;
    if (Ln < NLAT) { sn.so.map((int)Ln, u); u.pn = u.pn < 4 ? u.pn : u.pn + 16; return true; }
    const int r = (int)(Ln - NLAT);
    u.pm = ML / 256 + r % (MC / 256);
    const int idx = r / (MC / 256);
    u.pn = idx < 2 ? 2 + idx : 28;
    return true;
  }
  __device__ __forceinline__ void a_ready(const pg8::Unit&) const {}
  __device__ __forceinline__ void done(const pg8::Unit&) const {}
};
struct GEpiHgT {
  static constexpr bool PERM = true, AFTER_DRAIN = false;
  bf16 *HGQ, *HGF, *HGI; const float* hg_lb;
  __device__ __forceinline__ void operator()(const f32x4 (&acc)[2][2][4][2], const pg8::Unit& u, int wr, int wc, int fr, int fq) const {
    const int plane = u.pm >> 2;
    bf16* base; if (plane == 0) base = HGQ; else if (plane == 3) base = HGI; else base = HGF + (size_t)(plane - 1) * M * 1024;
    const bool isf = plane == 1 || plane == 2;
    const int m0 = u.pn * 256 + wc * 32 + 8 * fq;
#pragma unroll
    for (int ai = 0; ai < 2; ++ai)
#pragma unroll
      for (int m = 0; m < 4; ++m) {
        const int col = ((u.pm & 3) * 256) + ai * 128 + wr * 64 + m * 16 + fr;
        float oml = 1.f;
        if (isf) oml = __builtin_amdgcn_rcpf(1.0f + __expf(hg_lb[1024 + col] - hg_lb[col]));
        bf16* rowp = base + ((size_t)(m0 >> 5) * 1024 + col) * 32 + (m0 & 31);
#pragma unroll
        for (int bj = 0; bj < 2; ++bj) {
          f32x4 o0 = acc[ai][bj][m][0], o1 = acc[ai][bj][m][1];
          if (isf) {
#pragma unroll
            for (int j = 0; j < 4; ++j) { o0[j] = oml * __builtin_amdgcn_rcpf(1.0f + __expf(o0[j])); o1[j] = oml * __builtin_amdgcn_rcpf(1.0f + __expf(o1[j])); }
          }
          *(u32x4*)(rowp + (size_t)bj * 4 * 1024 * 32) = pack8<false>(o0, o1);
        }
      }
  }
};

struct GEpiIn1All {
  static constexpr bool PERM = true, AFTER_DRAIN = false;
  GEpiIn1 n; GEpiHgT t;
  __device__ __forceinline__ void operator()(const f32x4 (&acc)[2][2][4][2], const pg8::Unit& u, int wr, int wc, int fr, int fq) const {
    if (u.kind) t(acc, u, wr, wc, fr, fq); else n(acc, u, wr, wc, fr, fq);
  }
};
__device__ __forceinline__ unsigned pk2(float lo, float hi) { return pg8::cvt_pk_bf16(lo, hi); }
__device__ __forceinline__ void transpose_item(const float* __restrict__ W, int K, int N, bf16* __restrict__ WT, int k0, int nsrc, int ndst, LAS float* scr, int lane) {
  if (nsrc >= 0) {
    f32x4 t[8];
#pragma unroll
    for (int i = 0; i < 8; ++i) t[i] = *(const f32x4*)(W + (size_t)(k0 + (lane >> 3) + 8 * i) * N + nsrc + (lane & 7) * 4);
#pragma unroll
    for (int i = 0; i < 8; ++i) { LAS float* d = scr + ((lane >> 3) + 8 * i) * 33 + (lane & 7) * 4; d[0] = t[i][0]; d[1] = t[i][1]; d[2] = t[i][2]; d[3] = t[i][3]; }
  }
  asm volatile("s_waitcnt vmcnt(0) lgkmcnt(0)" ::: "memory");
  const int c = lane & 7;
#pragma unroll
  for (int j = 0; j < 4; ++j) {
    const int n = (lane >> 3) + 8 * j; const LAS float* sp = scr + (8 * c) * 33 + n;
    u32x4 o;
    if (nsrc >= 0) { o.x = pk2(sp[0 * 33], sp[1 * 33]); o.y = pk2(sp[2 * 33], sp[3 * 33]); o.z = pk2(sp[4 * 33], sp[5 * 33]); o.w = pk2(sp[6 * 33], sp[7 * 33]); }
    else { o.x = 0; o.y = 0; o.z = 0; o.w = 0; }
    *(u32x4*)(WT + (size_t)(ndst + n) * K + k0 + 8 * c) = o;
  }
  asm volatile("s_waitcnt lgkmcnt(0)" ::: "memory");
}
__device__ __forceinline__ int in1_src(int nd) {
  if (nd < 1024) return nd;
  if (nd < 7168) return nd + 64;
  if (nd < 7232) return nd - 7168 + 1024;
  return -1;
}
template <int KIND>
__device__ __forceinline__ void transpose_matrix(const float* W, int K, int N, int Ndst, bf16* WT, int gw, int ngw, LAS float* scr, int lane) {
  const int nblk = Ndst / 32, items = (K / 64) * nblk;
  for (int it = gw; it < items; it += ngw) {
    const int kb = it / nblk, nb = it % nblk;
    const int nd = nb * 32, ns = KIND == 1 ? in1_src(nd) : nd;
    transpose_item(W, K, N, WT, kb * 64, ns, nd, scr, lane);
  }
}


namespace att {
using bf16x8 = __attribute__((ext_vector_type(8))) short;
using s16x4 = __attribute__((ext_vector_type(4))) short;
using f32x16 = __attribute__((ext_vector_type(16))) float;
using u32x4 = __attribute__((ext_vector_type(4))) unsigned;
constexpr int SHM_V = 64 * 128 * 2, SHM_K = 64 * 128 * 2, SHM_P = 64 * 64 * 2;
constexpr int OFF_V = 0, OFF_K = 2 * SHM_V, OFF_P = OFF_K + 2 * SHM_K, OFF_WS = OFF_P + 2 * SHM_P, OFF_TAB = OFF_WS + 8 * 64 * 4, OFF_QP = OFF_TAB + 2048, LDS_ATT = OFF_QP + 8 * 8192;
#define KSWZ(row, colB) ((row) * 256 + ((colB) ^ (((row) & 7) << 4)))
#define PSWZ(row, colB) ((row) * 128 + ((colB) ^ (((row) & 7) << 4)))
#define SBAR() __builtin_amdgcn_sched_barrier(0)
__device__ __forceinline__ int crow(int r, int hi) { return (r & 3) + 8 * (r >> 2) + 4 * hi; }
__device__ __forceinline__ unsigned cvtpk(float lo, float hi) {
  unsigned r; asm volatile("v_cvt_pk_bf16_f32 %0, %1, %2" : "=v"(r) : "v"(lo), "v"(hi)); return r;
}
__device__ __forceinline__ bf16x8 ld8(const bf16* p) { return *reinterpret_cast<const bf16x8*>(p); }
constexpr float THR = 8.f;
__device__ __forceinline__ void partialSM(f32x16& p0, f32x16& p1, float& m_reg, float& mn, float& alpha, const float SCALE) {
  const float C = SCALE * 1.4426950408889634f;
  float pmax = p0[0];
#pragma unroll
  for (int r = 1; r < 16; ++r) pmax = fmaxf(pmax, p0[r]);
#pragma unroll
  for (int r = 0; r < 16; ++r) pmax = fmaxf(pmax, p1[r]);
  { auto rr = __builtin_amdgcn_permlane32_swap(__float_as_uint(pmax), __float_as_uint(pmax), false, false);
    pmax = fmaxf(__uint_as_float(rr[0]), __uint_as_float(rr[1])); }
  if (__builtin_expect(__all(pmax - m_reg <= THR / SCALE), 1)) { mn = m_reg; alpha = 1.f; }
  else { mn = fmaxf(m_reg, pmax); alpha = __builtin_amdgcn_exp2f((m_reg - mn) * C); m_reg = mn; }
  float mnC = -mn * C;
#pragma unroll
  for (int r = 0; r < 16; ++r) p0[r] = fmaf(p0[r], C, mnC);
#pragma unroll
  for (int r = 0; r < 16; ++r) p1[r] = fmaf(p1[r], C, mnC);
#pragma unroll
  for (int r = 0; r < 16; ++r) p0[r] = __builtin_amdgcn_exp2f(p0[r]);
}
__device__ __forceinline__ void finishSM(f32x16& p0, f32x16& p1, float alpha, float& l_reg, bf16x8& pa0, bf16x8& pa1, bf16x8& pa2, bf16x8& pa3) {
#pragma unroll
  for (int r = 0; r < 16; ++r) p1[r] = __builtin_amdgcn_exp2f(p1[r]);
  float ps = 0;
#pragma unroll
  for (int r = 0; r < 16; ++r) ps += p0[r];
#pragma unroll
  for (int r = 0; r < 16; ++r) ps += p1[r];
  { auto rr = __builtin_amdgcn_permlane32_swap(__float_as_uint(ps), __float_as_uint(ps), false, false);
    ps = __uint_as_float(rr[0]) + __uint_as_float(rr[1]); }
  l_reg = l_reg * alpha + ps;
#define PK4(P, BASE, OUT) do { unsigned a0 = cvtpk(P[BASE + 0], P[BASE + 1]), a1 = cvtpk(P[BASE + 2], P[BASE + 3]);   \
    unsigned b0 = cvtpk(P[BASE + 4], P[BASE + 5]), b1 = cvtpk(P[BASE + 6], P[BASE + 7]);                              \
    auto r0 = __builtin_amdgcn_permlane32_swap(a0, b0, false, false); auto r1 = __builtin_amdgcn_permlane32_swap(a1, b1, false, false); \
    u32x4 w = {r0[0], r1[0], r0[1], r1[1]}; OUT = *reinterpret_cast<bf16x8*>(&w); } while (0)
  PK4(p0, 0, pa0); PK4(p0, 8, pa1); PK4(p1, 0, pa2); PK4(p1, 8, pa3);
#undef PK4
}
template <bool HAS_PE, int NQR>
__device__ __forceinline__ void qkt(f32x16& p0, f32x16& p1, const LAS char* Ks, const LAS char* Ps, const bf16x8* qr, const LAS char* qp, int r32, int hi) {
  p0 = f32x16{}; p1 = f32x16{};
#pragma unroll
  for (int d0 = 0; d0 < 8; ++d0) { int cb = (d0 * 16 + hi * 8) * 2;
    bf16x8 b0 = *reinterpret_cast<const LAS bf16x8*>(Ks + KSWZ(r32, cb));
    bf16x8 b1 = *reinterpret_cast<const LAS bf16x8*>(Ks + KSWZ(32 + r32, cb));
    bf16x8 qf;
    if (d0 >= NQR) qf = *reinterpret_cast<const LAS bf16x8*>(qp + ((HAS_PE ? 4 : 0) + d0 - NQR) * 8192); else qf = qr[d0];
    p0 = __builtin_amdgcn_mfma_f32_32x32x16_bf16(b0, qf, p0, 0, 0, 0);
    p1 = __builtin_amdgcn_mfma_f32_32x32x16_bf16(b1, qf, p1, 0, 0, 0); }
  if constexpr (HAS_PE) {
#pragma unroll
    for (int d0 = 0; d0 < 4; ++d0) { int cb = (d0 * 16 + hi * 8) * 2;
      bf16x8 b0 = *reinterpret_cast<const LAS bf16x8*>(Ps + PSWZ(r32, cb));
      bf16x8 b1 = *reinterpret_cast<const LAS bf16x8*>(Ps + PSWZ(32 + r32, cb));
      const bf16x8 qf = *reinterpret_cast<const LAS bf16x8*>(qp + d0 * 8192);
      p0 = __builtin_amdgcn_mfma_f32_32x32x16_bf16(b0, qf, p0, 0, 0, 0);
      p1 = __builtin_amdgcn_mfma_f32_32x32x16_bf16(b1, qf, p1, 0, 0, 0); }
  }
}
__device__ __forceinline__ int v_st(int k, int c) { const int kk = (k & ~0xC) | ((k & 4) << 1) | ((k & 8) >> 1); return ((kk >> 3) * 4 + (c >> 5)) * 512 + ((kk & 7) * 32 + (c & 31)) * 2; }
__device__ __forceinline__ int v_rd_base(int lane) { return ((lane & 3) << 3) | (((lane >> 2) & 3) << 6) | (((lane >> 4) & 1) << 5) | (((lane >> 5) & 1) << 8); }
constexpr int v_rd_off(int d0, int ks, int half) { return d0 * 512 + ks * 4096 + half * 2048; }
template <int OFF> __device__ __forceinline__ s16x4 tr_read(int vb) {
  s16x4 r; asm volatile("ds_read_b64_tr_b16 %0, %1 offset:%2" : "=&v"(r) : "v"(vb), "i"(OFF) : "memory"); return r;
}
template <int D0> __device__ __forceinline__ void pv_one(f32x16& od, int vb, bf16x8 pa0, bf16x8 pa1, bf16x8 pa2, bf16x8 pa3) {
  const s16x4 l0 = tr_read<v_rd_off(D0, 0, 0)>(vb), h0 = tr_read<v_rd_off(D0, 0, 1)>(vb), l1 = tr_read<v_rd_off(D0, 1, 0)>(vb), h1 = tr_read<v_rd_off(D0, 1, 1)>(vb);
  const s16x4 l2 = tr_read<v_rd_off(D0, 2, 0)>(vb), h2 = tr_read<v_rd_off(D0, 2, 1)>(vb), l3 = tr_read<v_rd_off(D0, 3, 0)>(vb), h3 = tr_read<v_rd_off(D0, 3, 1)>(vb);
  asm volatile("s_waitcnt lgkmcnt(0)" ::: "memory"); SBAR();
#define PK(L, H) (bf16x8){L[0], L[1], L[2], L[3], H[0], H[1], H[2], H[3]}
  od = __builtin_amdgcn_mfma_f32_32x32x16_bf16(pa0, PK(l0, h0), od, 0, 0, 0);
  od = __builtin_amdgcn_mfma_f32_32x32x16_bf16(pa1, PK(l1, h1), od, 0, 0, 0);
  od = __builtin_amdgcn_mfma_f32_32x32x16_bf16(pa2, PK(l2, h2), od, 0, 0, 0);
  od = __builtin_amdgcn_mfma_f32_32x32x16_bf16(pa3, PK(l3, h3), od, 0, 0, 0);
#undef PK
}
__device__ __forceinline__ void pv_d0(f32x16* o, int vb, bf16x8 pa0, bf16x8 pa1, bf16x8 pa2, bf16x8 pa3) {
  pv_one<0>(o[0], vb, pa0, pa1, pa2, pa3); pv_one<1>(o[1], vb, pa0, pa1, pa2, pa3); pv_one<2>(o[2], vb, pa0, pa1, pa2, pa3); pv_one<3>(o[3], vb, pa0, pa1, pa2, pa3);
}
struct TileSrc { const bf16* K; const bf16* V; const bf16* P; };
template <bool HAS_PE, bool HAS_BIAS, int NQR, int ldq, int ldk, int ldo, class Src, class Bias>
__device__ __forceinline__ void attn_body(const bf16* __restrict__ Qb, const Src& src, const Bias& bias, const int NTILES, const float SCALE,
                                          bf16* __restrict__ Ob, const bf16* __restrict__ Gb, LAS char* lds, const int wave_s) {
  const int tid = fresh_tid(wave_s);
  const int wid = tid >> 6, lane = tid & 63, r32 = lane & 31, hi = lane >> 5;
  LAS char* V_lds = lds + OFF_V; LAS char* K_lds = lds + OFF_K; LAS char* P_lds = lds + OFF_P;
  LAS float* ws = (LAS float*)(lds + OFF_WS) + wid * 64; LAS float* li_l = ws; LAS float* al_l = ws + 32;
  float m_reg = -1e30f, l_reg = 0; f32x16 o[4] = {}; bf16x8 qr[NQR > 0 ? NQR : 1];
  const bf16* Qw = Qb + (long)(wid * 32 + r32) * ldq + hi * 8;
#pragma unroll
  for (int d0 = 0; d0 < NQR; ++d0) qr[d0] = ld8(Qw + d0 * 16);
  LAS char* qp = lds + OFF_QP + (wid * 64 + lane) * 16;
  if constexpr (HAS_PE) {
#pragma unroll
    for (int d0 = 0; d0 < 4; ++d0) *(LAS bf16x8*)(qp + d0 * 8192) = ld8(Qw + 128 + d0 * 16);
  }
#pragma unroll
  for (int d0 = NQR; d0 < 8; ++d0) *(LAS bf16x8*)(qp + ((HAS_PE ? 4 : 0) + d0 - NQR) * 8192) = ld8(Qw + d0 * 16);
  const int sr = tid >> 4, sc = (tid & 15) * 8, vst0 = v_st(sr, sc), vst1 = v_st(32 + sr, sc);
  const int pr = tid >> 3, pc = (tid & 7) * 8;
  const int vb0 = (int)(uintptr_t)V_lds + v_rd_base(lane);
  struct { bf16x8 vs0, vs1, ks0, ks1, ps; } sr_[2];
#define SLOAD(i, tile) do { const TileSrc ts_ = src(tile); sr_[i].vs0 = ld8(ts_.V + (long)sr * ldk + sc); sr_[i].vs1 = ld8(ts_.V + (long)(32 + sr) * ldk + sc); \
    sr_[i].ks0 = ld8(ts_.K + (long)sr * ldk + sc); sr_[i].ks1 = ld8(ts_.K + (long)(32 + sr) * ldk + sc); \
    if constexpr (HAS_PE) sr_[i].ps = ld8(ts_.P + pr * 64 + pc); } while (0)
#define SWRITE(b, i) do { *(LAS bf16x8*)(V_lds + (b) * SHM_V + vst0) = sr_[i].vs0;          \
    *(LAS bf16x8*)(V_lds + (b) * SHM_V + vst1) = sr_[i].vs1; int kc = sc * 2;               \
    *(LAS bf16x8*)(K_lds + (b) * SHM_K + KSWZ(sr, kc)) = sr_[i].ks0;                       \
    *(LAS bf16x8*)(K_lds + (b) * SHM_K + KSWZ(32 + sr, kc)) = sr_[i].ks1;                  \
    if constexpr (HAS_PE) *(LAS bf16x8*)(P_lds + (b) * SHM_P + PSWZ(pr, pc * 2)) = sr_[i].ps; } while (0)
#define SWAIT() do { if constexpr (HAS_PE) asm volatile("s_waitcnt vmcnt(5)" ::: "memory"); else asm volatile("s_waitcnt vmcnt(4)" ::: "memory"); } while (0)
#define RESC(a) do { if (__any((a) < 1.f)) { if (hi == 0) al_l[r32] = (a); asm volatile("s_waitcnt lgkmcnt(0)" ::: "memory"); \
    _Pragma("unroll") for (int d = 0; d < 4; ++d) _Pragma("unroll") for (int r = 0; r < 16; ++r) o[d][r] *= al_l[crow(r, hi)]; } } while (0)
  f32x16 pA0, pA1, pB0, pB1; float mnA, mnB, alA, alB; bf16x8 pa0, pa1, pa2, pa3; const int NT_ = NTILES;
  constexpr int SE = 0, SO = 1;
  SLOAD(SE, 0); asm volatile("s_waitcnt vmcnt(0)" ::: "memory"); SWRITE(0, SE); __syncthreads();
  qkt<HAS_PE, NQR>(pA0, pA1, K_lds, P_lds, qr, qp, r32, hi); if constexpr (HAS_BIAS) bias(pA0, pA1, 0, wid, r32, hi); partialSM(pA0, pA1, m_reg, mnA, alA, SCALE);
  SLOAD(SO, 1); if (2 < NT_) SLOAD(SE, 2);
  SWAIT(); SWRITE(1, SO); __syncthreads();
  for (int j = 1; j + 1 < NT_; j += 2) {
    SBAR(); qkt<HAS_PE, NQR>(pB0, pB1, K_lds + SHM_K, P_lds + SHM_P, qr, qp, r32, hi);
    finishSM(pA0, pA1, alA, l_reg, pa0, pa1, pa2, pa3); SBAR();
    SLOAD(SO, j + 2 < NT_ ? j + 2 : j); SBAR();
    pv_d0(o, vb0, pa0, pa1, pa2, pa3); if constexpr (HAS_BIAS) bias(pB0, pB1, j, wid, r32, hi); partialSM(pB0, pB1, m_reg, mnB, alB, SCALE);
    __syncthreads(); SWAIT(); SWRITE(0, SE);
    RESC(alB); __syncthreads();
    SBAR(); qkt<HAS_PE, NQR>(pA0, pA1, K_lds, P_lds, qr, qp, r32, hi);
    finishSM(pB0, pB1, alB, l_reg, pa0, pa1, pa2, pa3); SBAR();
    if (j + 3 < NT_) SLOAD(SE, j + 3); SBAR();
    pv_d0(o, vb0 + SHM_V, pa0, pa1, pa2, pa3); if constexpr (HAS_BIAS) bias(pA0, pA1, j + 1, wid, r32, hi); partialSM(pA0, pA1, m_reg, mnA, alA, SCALE);
    __syncthreads(); SWAIT(); SWRITE(1, SO);
    RESC(alA); __syncthreads();
  }
  SBAR(); qkt<HAS_PE, NQR>(pB0, pB1, K_lds + SHM_K, P_lds + SHM_P, qr, qp, r32, hi);
  finishSM(pA0, pA1, alA, l_reg, pa0, pa1, pa2, pa3); SBAR();
  pv_d0(o, vb0, pa0, pa1, pa2, pa3); if constexpr (HAS_BIAS) bias(pB0, pB1, NT_ - 1, wid, r32, hi); partialSM(pB0, pB1, m_reg, mnB, alB, SCALE);
  __syncthreads(); RESC(alB);
  finishSM(pB0, pB1, alB, l_reg, pa0, pa1, pa2, pa3); SBAR();
  pv_d0(o, vb0 + SHM_V, pa0, pa1, pa2, pa3);
  if (hi == 0) li_l[r32] = l_reg; asm volatile("s_waitcnt lgkmcnt(0)" ::: "memory");
  float rli[16];
#pragma unroll
  for (int r = 0; r < 16; ++r) rli[r] = __builtin_amdgcn_rcpf(li_l[crow(r, hi)]);
  bf16* Ow = Ob + (long)(wid * 32) * ldo; const bf16* Gw = Gb + (long)(wid * 32) * ldo;
#pragma unroll
  for (int r = 0; r < 16; ++r) { const int orow = crow(r, hi);
#pragma unroll
    for (int d0 = 0; d0 < 4; ++d0) { const long idx = (long)orow * ldo + d0 * 32 + r32; Ow[idx] = f2bf(o[d0][r] * rli[r] * bf2f(Gw[idx])); }
    asm volatile("" ::: "memory"); }
#undef SLOAD
#undef SWRITE
#undef SWAIT
#undef RESC
}
static_assert(LDS_ATT <= LDS_BYTES, "attention LDS");
struct NoBias { __device__ __forceinline__ void operator()(f32x16&, f32x16&, int, int, int, int) const {} };
}

struct MlaSrc {
  const bf16 *K, *V, *P;
  __device__ __forceinline__ att::TileSrc operator()(int tile) const { return {K + (long)tile * 64 * 2048, V + (long)tile * 64 * 2048, P + (long)tile * 64 * 64}; }
};
__device__ __forceinline__ void mla_phase(const Params& p, int bid, int nb, LAS unsigned char* lds, const int wave_s) {
  constexpr int NQB = SEQ / 256, NU = BATCH * 8 * NQB;
  for (int unit = bid; unit < NU; unit += nb) {
    const int qb = unit % NQB, h = (unit / NQB) % 8, b = unit / (NQB * 8);
    const long m0 = (long)b * SEQ + qb * 256, kv0 = (long)b * (SEQ + CTX);
    MlaSrc src{p.KV + kv0 * 2048 + h * 256, p.KV + kv0 * 2048 + h * 256 + 128, p.KPE + kv0 * 64};
    __syncthreads();
    att::attn_body<true, false, 6, 1536, 2048, 2048>(p.Q + m0 * 1536 + h * 192, src, att::NoBias{}, (SEQ + CTX) / 64, 0.07216878364870322f,
                                                  p.YALL + m0 * 2048 + h * 128, p.G1 + m0 * 2048 + h * 128, (LAS char*)lds, wave_s);
  }
}


struct NaSrc {
  const bf16* base;
  int b, kr_lo, nloc;
  __device__ __forceinline__ att::TileSrc operator()(int tile) const {
    long row;
    if (tile < nloc) { int kr = kr_lo + tile; kr = kr < ROWS ? kr : ROWS - 1; row = (long)b * SEQ + kr * GW; }
    else row = ML + (long)b * CTX + (tile - nloc) * 64;
    const bf16* r = base + row * 3072;
    return {r + 1024, r + 2048, nullptr};
  }
};
struct NaBias {
  const LAS float* tab;
  int u, kr_lo;
  __device__ __forceinline__ void operator()(att::f32x16& p0, att::f32x16& p1, int tile, int wid, int r32, int hi) const {
    if (tile >= 12) return;
    const int kr = kr_lo + tile, rq = 4 * u + (wid >> 1), r0 = clampi(rq - 4, 0, ROWS - 8);
    const float NEG = -__builtin_inff();
    if (kr < r0 || kr >= r0 + 8) {
#pragma unroll
      for (int r = 0; r < 16; ++r) { p0[r] = NEG; p1[r] = NEG; }
      return;
    }
    const int j = (wid & 1) * 32 + r32, c0 = clampi(j - 8, 0, GW - 16);
    const LAS float* trow = tab + (kr - rq + 7) * 31 + (15 - j);
#pragma unroll
    for (int r = 0; r < 16; ++r) {
      const int c = att::crow(r, hi);
      const bool v0 = (c >= c0) && (c < c0 + 16), v1 = (c + 32 >= c0) && (c + 32 < c0 + 16);
      const float b0 = trow[v0 ? c : j], b1 = trow[v1 ? c + 32 : j];
      p0[r] = v0 ? p0[r] + b0 : NEG;
      p1[r] = v1 ? p1[r] + b1 : NEG;
      if ((r & 3) == 3) asm volatile("" ::: "memory");
    }
  }
};
constexpr int NA_NUL = BATCH * 8 * (ROWS / 4), NA_NUC = BATCH * 8 * (CTX / 256);
__device__ __forceinline__ void na_phase(const Params& p, int first, int stride, unsigned* ctr, int dyn0, LAS unsigned char* lds, const int wave_s) {
  constexpr int NUL = NA_NUL, NUC = NA_NUC;
  const float scale = 0.08838834764831845f;
  for (int unit = first;; unit = ctr ? -1 : unit + stride) {
    __syncthreads();
    if (unit < 0) {
      volatile LAS int* slot = (volatile LAS int*)(lds + att::LDS_ATT);
      if (fresh_tid(wave_s) == 0) *slot = dyn0 + (int)__hip_atomic_fetch_add(ctr, 1u, __ATOMIC_RELAXED, __HIP_MEMORY_SCOPE_AGENT);
      __syncthreads();
      unit = __builtin_amdgcn_readfirstlane(*slot);
    }
    if (unit >= NUL + NUC) break;
    if (unit < NUL) {
      const int u = unit % (ROWS / 4), h = (unit / (ROWS / 4)) % 8, b = unit / ((ROWS / 4) * 8);
      const int kr_lo = clampi(4 * u - 4, 0, ROWS - 8);
      LAS float* tab = (LAS float*)(lds + att::OFF_TAB);
      { const int tid = fresh_tid(wave_s); if (tid < 465) tab[tid] = p.na_rpb[h * 465 + tid] * (1.0f / scale); }
      const long m0 = (long)b * SEQ + u * 256;
      NaSrc src{p.QKV0 + h * 128, b, kr_lo, 12};
      att::attn_body<false, true, 0, 3072, 3072, 2048>(p.QKV0 + m0 * 3072 + h * 128, src, NaBias{tab, u, kr_lo}, 16, scale,
                                                    p.YALL + m0 * 2048 + h * 128, p.G0 + m0 * 2048 + h * 128, (LAS char*)lds, wave_s);
    } else {
      const int uc = unit - NUL, qb = uc % (CTX / 256), h = (uc / (CTX / 256)) % 8, b = uc / ((CTX / 256) * 8);
      const long m0 = ML + (long)b * CTX + qb * 256;
      NaSrc src{p.QKV0 + h * 128, b, 0, 0};
      att::attn_body<false, false, 2, 3072, 3072, 2048>(p.QKV0 + m0 * 3072 + h * 128, src, att::NoBias{}, CTX / 64, scale,
                                                     p.YALL + m0 * 2048 + h * 128, p.G0 + m0 * 2048 + h * 128, (LAS char*)lds, wave_s);
    }
  }
}


constexpr int RW_TB = 32, RW_SLOT = 48, RW_BUF = RW_TB * 16 * RW_SLOT, RW_VOFF = 2 * RW_BUF, RW_VBUF = RW_TB * 32 * 2;
typedef unsigned u32x2 __attribute__((ext_vector_type(2)));
typedef _Float16 h8 __attribute__((ext_vector_type(8)));
typedef _Float16 h4 __attribute__((ext_vector_type(4)));
__device__ __forceinline__ float mix_lo(float a, unsigned h2, float c) { float d; asm("v_fma_mix_f32 %0, %1, %2, %3 op_sel_hi:[0,1,0]" : "=v"(d) : "v"(a), "v"(h2), "v"(c)); return d; }
__device__ __forceinline__ float mix_hi(float a, unsigned h2, float c) { float d; asm("v_fma_mix_f32 %0, %1, %2, %3 op_sel:[0,1,0] op_sel_hi:[0,1,0]" : "=v"(d) : "v"(a), "v"(h2), "v"(c)); return d; }
__device__ __forceinline__ float mix_hi_nop(float a, unsigned h2, float c) { float d; asm("v_fma_mix_f32 %0, %1, %2, %3 op_sel:[0,1,0] op_sel_hi:[0,1,0]\n\ts_nop 1" : "=v"(d) : "v"(a), "v"(h2), "v"(c)); return d; }
__device__ __forceinline__ float row_allreduce16(float x) {
  x += __builtin_bit_cast(float, __builtin_amdgcn_update_dpp(0, __builtin_bit_cast(int, x), 0x128, 0xf, 0xf, false));
  x += __builtin_bit_cast(float, __builtin_amdgcn_update_dpp(0, __builtin_bit_cast(int, x), 0x124, 0xf, 0xf, false));
  x += __builtin_bit_cast(float, __builtin_amdgcn_update_dpp(0, __builtin_bit_cast(int, x), 0x122, 0xf, 0xf, false));
  x += __builtin_bit_cast(float, __builtin_amdgcn_update_dpp(0, __builtin_bit_cast(int, x), 0x121, 0xf, 0xf, false));
  return x;
}
__device__ __forceinline__ long rw_row(int d, int b, int g) { return seq_row(d, b, g); }
__device__ __forceinline__ void rwkv_scan_phase(const Params& p, int bid, int nb, LAS unsigned char* lds, const int wave_s) {
  constexpr int NBLK = (CTX + SEQ) / RW_TB, NCH = 5 * RW_TB * 8 + RW_TB * 4, NIT = (NCH + NT - 1) / NT;
  for (int unit = bid; unit < 2 * 16 * BATCH * 2; unit += nb) {
    const int tid = fresh_tid(wave_s), lane = tid & 63;
    const int half = unit & 1, scan = unit >> 1, h = scan % 16, b = (scan / 16) % BATCH, d = scan / (16 * BATCH);
    const int rowl = wave_s * 4 + (lane >> 4), kg = lane & 15;
    float S0 = 0.f, S1 = 0.f, S2 = 0.f, S3 = 0.f;
    u32x4 st[NIT];
    __syncthreads();
    auto gload = [&](int blk) {
#pragma unroll
      for (int it = 0; it < NIT; ++it) {
        const int c = tid + it * NT;
        if (c < 5 * RW_TB * 8) {
          const int a = c / (RW_TB * 8), sidx = (c % (RW_TB * 8)) >> 3, part = c & 7;
          const int aidx = ((0x05237 >> (4 * a)) & 15) + (((0x0B >> a) & 1) ? d : 0);
          st[it] = *(const u32x4*)(p.R + (long)aidx * M * 1024 + rw_row(d, b, blk * RW_TB + sidx) * 1024 + h * 64 + part * 8);
        } else if (c < NCH) {
          const int c2 = c - 5 * RW_TB * 8, sidx = c2 >> 2, part = c2 & 3;
          st[it] = *(const u32x4*)(p.V + rw_row(d, b, blk * RW_TB + sidx) * 1024 + h * 64 + half * 32 + part * 8);
        }
      }
    };
    auto lwrite = [&](int buf) {
#pragma unroll
      for (int it = 0; it < NIT; ++it) {
        const int c = tid + it * NT;
        if (c < 5 * RW_TB * 8) {
          const int a = c / (RW_TB * 8), sidx = (c % (RW_TB * 8)) >> 3, part = c & 7;
          LAS unsigned char* dst = lds + buf * RW_BUF + (sidx * 16 + 2 * part) * RW_SLOT + a * 8;
          *(LAS u32x2*)(dst) = (u32x2){st[it].x, st[it].y};
          *(LAS u32x2*)(dst + RW_SLOT) = (u32x2){st[it].z, st[it].w};
        } else if (c < NCH) {
          const int c2 = c - 5 * RW_TB * 8, sidx = c2 >> 2, part = c2 & 3;
          *(LAS u32x4*)(lds + RW_VOFF + buf * RW_VBUF + (sidx * 32 + part * 8) * 2) = st[it];
        }
      }
    };
    gload(0);
    lwrite(0);
    __syncthreads();
    LAS f16* ybuf = (LAS f16*)(lds + RW_VOFF + 2 * RW_VBUF);
    auto yflush = [&](int blk) {
      if (tid < RW_TB * 4) {
        const int sidx = tid >> 2, part = tid & 3;
        const u32x4 v = *(const LAS u32x4*)(ybuf + (blk & 1) * RW_TB * 32 + sidx * 32 + part * 8);
        *(u32x4*)(p.Yd + (long)d * M * 1024 + rw_row(d, b, blk * RW_TB + sidx) * 1024 + h * 64 + half * 32 + part * 8) = v;
      }
    };
    for (int blk = 0; blk < NBLK; ++blk) {
      const int buf = blk & 1;
      if (blk + 1 < NBLK) gload(blk + 1);
      if (blk > 0) yflush(blk - 1);
      const LAS unsigned char* sl = lds + buf * RW_BUF + kg * RW_SLOT;
      const LAS f16* vb = (const LAS f16*)(lds + RW_VOFF + buf * RW_VBUF) + rowl;
      LAS f16* yb = ybuf + buf * RW_TB * 32 + rowl;
      u32x4 q0n = *(const LAS u32x4*)(sl), q1n = *(const LAS u32x4*)(sl + 16);
      u32x2 q2n = *(const LAS u32x2*)(sl + 32);
      f16 vvn = vb[0];
#pragma unroll 4
      for (int s2 = 0; s2 < RW_TB; ++s2) {
        const u32x4 q0 = q0n, q1 = q1n; const u32x2 q2 = q2n; const float vv = (float)vvn;
        const int sn = (s2 + 1 < RW_TB) ? s2 + 1 : s2;
        const LAS unsigned char* sp = sl + sn * 16 * RW_SLOT;
        q0n = *(const LAS u32x4*)(sp); q1n = *(const LAS u32x4*)(sp + 16); q2n = *(const LAS u32x2*)(sp + 32);
        vvn = vb[sn * 32];
        float sa = mix_lo(S0, q1.x, 0.f);
        sa = mix_hi(S1, q1.x, sa); sa = mix_lo(S2, q1.y, sa); sa = mix_hi_nop(S3, q1.y, sa);
        sa = row_allreduce16(sa);
        S0 = mix_lo(S0, q0.x, S0); S1 = mix_hi(S1, q0.x, S1); S2 = mix_lo(S2, q0.y, S2); S3 = mix_hi(S3, q0.y, S3);
        S0 = mix_lo(sa, q1.z, S0); S1 = mix_hi(sa, q1.z, S1); S2 = mix_lo(sa, q1.w, S2); S3 = mix_hi(sa, q1.w, S3);
        S0 = mix_lo(vv, q0.z, S0); S1 = mix_hi(vv, q0.z, S1); S2 = mix_lo(vv, q0.w, S2); S3 = mix_hi(vv, q0.w, S3);
        float y = mix_lo(S0, q2.x, 0.f);
        y = mix_hi(S1, q2.x, y); y = mix_lo(S2, q2.y, y); y = mix_hi_nop(S3, q2.y, y);
        y = row_allreduce16(y);
        yb[s2 * 32] = (f16)y;
      }
      if (blk + 1 < NBLK) lwrite(buf ^ 1);
      __syncthreads();
    }
    yflush(NBLK - 1);
  }
}


typedef __attribute__((ext_vector_type(8))) short hb8;
typedef __attribute__((ext_vector_type(4))) short hb4;
__device__ __forceinline__ hb8 join4(hb4 lo, hb4 hi) { return (hb8){lo[0], lo[1], lo[2], lo[3], hi[0], hi[1], hi[2], hi[3]}; }
typedef __bf16 nbf2 __attribute__((ext_vector_type(2)));
typedef float nf2 __attribute__((ext_vector_type(2)));
__device__ __forceinline__ unsigned cvt2(float lo, float hi) { return __builtin_bit_cast(unsigned, __builtin_convertvector((nf2){lo, hi}, nbf2)); }
__device__ __forceinline__ hb8 pack_acc(f32x4 t0, f32x4 t1) {
  u32x4 w = {cvt2(t0[0], t0[1]), cvt2(t0[2], t0[3]), cvt2(t1[0], t1[1]), cvt2(t1[2], t1[3])};
  return __builtin_bit_cast(hb8, w);
}
template <int V> struct ITag { static constexpr int v = V; };
__device__ __forceinline__ void hg_scan_phase(const Params& p, int unit0, int ustride, LAS unsigned char* lds, const int wave_s) {
  constexpr int NCHUNK = (CTX + SEQ) / HG_C;
  for (int unit4 = unit0; unit4 < 2 * BATCH * 8 * 2; unit4 += ustride) {
    const int tid = fresh_tid(wave_s), lane = tid & 63, l15 = lane & 15, g4 = lane >> 4;
    const int unit = unit4 >> 1, eq = unit4 & 1;
    const int h = unit % 8, b = (unit / 8) % BATCH, d = unit / (8 * BATCH);
    const int dd = 32 * (wave_s & 3) + (lane & 31), hf = lane >> 5;
    const bf16* fsrc = p.HGF + (long)d * M * 1024;
    const int es = eq * 64 + (wave_s & 3) * 16;
    f32x4 S[8];
#pragma unroll
    for (int t = 0; t < 8; ++t) S[t] = (f32x4){0.f, 0.f, 0.f, 0.f};
    u32x4 wq[2], wf[2], wv[2];
    const long rstep = d ? -1024 : 1024;
    auto pload = [&](int c) {
      const long r0 = seq_row(d, b, c * HG_C + (d ? HG_C - 1 : 0));
      const size_t o = ((size_t)(r0 >> 5) * 1024 + h * 128 + dd) * 32 + (d ? 1 - hf : hf) * 16;
      const u32x4* q = (const u32x4*)(p.HGQ + o); const u32x4* v = (const u32x4*)(p.HGI + o); const u32x4* f = (const u32x4*)(fsrc + o);
      wq[0] = q[0]; wq[1] = q[1]; wv[0] = v[0]; wv[1] = v[1]; wf[0] = f[0]; wf[1] = f[1];
    };
    auto prep = [&](int c, auto dirtag) {
      constexpr int DIR = decltype(dirtag)::v;
      LAS unsigned char* base = lds + (c & 1) * HG_LDS;
      LAS bf16* QI = (LAS bf16*)(base + HG_OFF_QI); LAS bf16* KI = (LAS bf16*)(base + HG_OFF_KI);
      LAS bf16* KET = (LAS bf16*)(base + HG_OFF_KET); LAS bf16* VT = (LAS bf16*)(base + HG_OFF_VT); LAS float* DEC = (LAS float*)(base + HG_OFF_DEC);
      float qv[16], kk[16], vv[16], bl[16];
      float run = 1.f;
#define HG_EL(w, j) (((j) & 1) ? __uint_as_float((w)[(j) >> 3][((j) >> 1) & 3] & 0xffff0000u) : __uint_as_float((w)[(j) >> 3][((j) >> 1) & 3] << 16))
#pragma unroll
      for (int r = 0; r < 16; ++r) {
        const int j = DIR ? 15 - r : r;
        qv[r] = HG_EL(wq, j); vv[r] = HG_EL(wv, j);
        kk[r] = HG_EL(wf, j);
        run *= 1.0f - kk[r];
        bl[r] = run;
      }
      __builtin_amdgcn_sched_barrier(0);
      pload(c + 1 < NCHUNK ? c + 1 : NCHUNK - 1);
      __builtin_amdgcn_sched_barrier(0);
      const float oth = __shfl_xor(run, 32);
      const float pre = hf ? oth : 1.f, tot = run * oth;
      unsigned ke[8], vt[8];
#pragma unroll
      for (int r = 0; r < 16; r += 2) {
        const float p0 = pre * bl[r], p1 = pre * bl[r + 1];
        const float i0v = __builtin_amdgcn_rcpf(p0), i1v = __builtin_amdgcn_rcpf(p1);
        const int i0 = hf * 16 + r;
        if (c >= CTX / HG_C) {
          QI[i0 * HG_LDQ + dd] = f2bf(qv[r] * p0); QI[(i0 + 1) * HG_LDQ + dd] = f2bf(qv[r + 1] * p1);
          KI[i0 * HG_LDQ + dd] = f2bf(kk[r] * i0v); KI[(i0 + 1) * HG_LDQ + dd] = f2bf(kk[r + 1] * i1v);
        }
        ke[r >> 1] = cvt2(kk[r] * (tot * i0v), kk[r + 1] * (tot * i1v));
        vt[r >> 1] = cvt2(vv[r], vv[r + 1]);
      }
      *(LAS u32x4*)(KET + dd * HG_LDT + hf * 16) = (u32x4){ke[0], ke[1], ke[2], ke[3]};
      *(LAS u32x4*)(KET + dd * HG_LDT + hf * 16 + 8) = (u32x4){ke[4], ke[5], ke[6], ke[7]};
      *(LAS u32x4*)(VT + dd * HG_LDT + hf * 16) = (u32x4){vt[0], vt[1], vt[2], vt[3]};
      *(LAS u32x4*)(VT + dd * HG_LDT + hf * 16 + 8) = (u32x4){vt[4], vt[5], vt[6], vt[7]};
      if (hf == 0) DEC[dd] = tot;
    };
    const bool prepw = wave_s >= 4, mma = wave_s < 4;
    __syncthreads();
    if (prepw) { pload(0); if (d) prep(0, ITag<1>{}); else prep(0, ITag<0>{}); }
    __syncthreads();
    if (prepw) {
      if (d) { for (int c = 0; c < NCHUNK; ++c) { if (c + 1 < NCHUNK) prep(c + 1, ITag<1>{}); WG_BAR_LDS(); } }
      else { for (int c = 0; c < NCHUNK; ++c) { if (c + 1 < NCHUNK) prep(c + 1, ITag<0>{}); WG_BAR_LDS(); } }
    } else if (!mma) {
      for (int c = 0; c < NCHUNK; ++c) WG_BAR_LDS();
    } else {
    for (int c = 0; c < NCHUNK; ++c) {
      LAS unsigned char* base = lds + (c & 1) * HG_LDS;
      const LAS bf16* QI = (const LAS bf16*)(base + HG_OFF_QI); const LAS bf16* KI = (const LAS bf16*)(base + HG_OFF_KI);
      const LAS bf16* KET = (const LAS bf16*)(base + HG_OFF_KET); const LAS bf16* VT = (const LAS bf16*)(base + HG_OFF_VT); const LAS float* DEC = (const LAS float*)(base + HG_OFF_DEC);
      {
      if (c >= CTX / HG_C) {
      f32x4 T00 = {0.f, 0.f, 0.f, 0.f}, T01 = T00, T11 = T00;
#pragma unroll
      for (int ks = 0; ks < 4; ++ks) {
        const hb8 a0 = *(const LAS hb8*)(KI + l15 * HG_LDQ + ks * 32 + g4 * 8);
        const hb8 a1 = *(const LAS hb8*)(KI + (16 + l15) * HG_LDQ + ks * 32 + g4 * 8);
        const hb8 b0 = *(const LAS hb8*)(QI + l15 * HG_LDQ + ks * 32 + g4 * 8);
        const hb8 b1 = *(const LAS hb8*)(QI + (16 + l15) * HG_LDQ + ks * 32 + g4 * 8);
        T00 = __builtin_amdgcn_mfma_f32_16x16x32_bf16(a0, b0, T00, 0, 0, 0);
        T01 = __builtin_amdgcn_mfma_f32_16x16x32_bf16(a0, b1, T01, 0, 0, 0);
        T11 = __builtin_amdgcn_mfma_f32_16x16x32_bf16(a1, b1, T11, 0, 0, 0);
      }
#pragma unroll
      for (int r = 0; r < 4; ++r) { if (4 * g4 + r > l15) { T00[r] = 0.f; T11[r] = 0.f; } }
      f32x4 O0 = {0.f, 0.f, 0.f, 0.f}, O1 = O0;
      {
        const hb4 vlo = *(const LAS hb4*)(VT + (es + l15) * HG_LDT + 4 * g4);
        const hb4 vhi = *(const LAS hb4*)(VT + (es + l15) * HG_LDT + 16 + 4 * g4);
        const hb8 bv = join4(vlo, vhi);
        const f32x4 Z = {0.f, 0.f, 0.f, 0.f};
        O0 = __builtin_amdgcn_mfma_f32_16x16x32_bf16(pack_acc(T00, Z), bv, O0, 0, 0, 0);
        O1 = __builtin_amdgcn_mfma_f32_16x16x32_bf16(pack_acc(T01, T11), bv, O1, 0, 0, 0);
      }
#pragma unroll
      for (int ks = 0; ks < 4; ++ks) {
        const hb8 sb = pack_acc(S[2 * ks], S[2 * ks + 1]);
        const hb8 q0 = join4(*(const LAS hb4*)(QI + l15 * HG_LDQ + ks * 32 + 4 * g4), *(const LAS hb4*)(QI + l15 * HG_LDQ + ks * 32 + 16 + 4 * g4));
        const hb8 q1 = join4(*(const LAS hb4*)(QI + (16 + l15) * HG_LDQ + ks * 32 + 4 * g4), *(const LAS hb4*)(QI + (16 + l15) * HG_LDQ + ks * 32 + 16 + 4 * g4));
        O0 = __builtin_amdgcn_mfma_f32_16x16x32_bf16(q0, sb, O0, 0, 0, 0);
        O1 = __builtin_amdgcn_mfma_f32_16x16x32_bf16(q1, sb, O1, 0, 0, 0);
      }
        f16* ob = p.O1d + (long)d * ML * 1024 + h * 128 + es + l15 + seq_row(d, b, c * HG_C + 4 * g4) * 1024;
#pragma unroll
        for (int r = 0; r < 4; ++r) {
          ob[r * rstep] = (f16)O0[r];
          ob[(16 + r) * rstep] = (f16)O1[r];
        }
      }
      {
        const hb8 bv = *(const LAS hb8*)(VT + (es + l15) * HG_LDT + g4 * 8);
#pragma unroll
        for (int t = 0; t < 8; ++t) {
          const f32x4 dc = *(const LAS f32x4*)(DEC + 16 * t + 4 * g4);
          const hb8 a = *(const LAS hb8*)(KET + (16 * t + l15) * HG_LDT + g4 * 8);
          S[t] = __builtin_amdgcn_mfma_f32_16x16x32_bf16(a, bv, S[t] * dc, 0, 0, 0);
        }
      }
      }
      WG_BAR_LDS();
    }
    }
  }
}


typedef float f32x8v __attribute__((ext_vector_type(8)));
__device__ __forceinline__ float xsum(float v, int width) {
  for (int o = 1; o < width; o <<= 1) v += __shfl_xor(v, o);
  return v;
}
__device__ __forceinline__ void ld8bf(const bf16* p, float* o) {
  const u32x4 w = *(const u32x4*)p;
  o[0] = __uint_as_float(w.x << 16); o[1] = __uint_as_float(w.x & 0xffff0000u); o[2] = __uint_as_float(w.y << 16); o[3] = __uint_as_float(w.y & 0xffff0000u);
  o[4] = __uint_as_float(w.z << 16); o[5] = __uint_as_float(w.z & 0xffff0000u); o[6] = __uint_as_float(w.w << 16); o[7] = __uint_as_float(w.w & 0xffff0000u);
}
__device__ __forceinline__ void st8bf(bf16* p, const float* v) {
  u32x4 w; w.x = pk2(v[0], v[1]); w.y = pk2(v[2], v[3]); w.z = pk2(v[4], v[5]); w.w = pk2(v[6], v[7]);
  *(u32x4*)p = w;
}
__device__ __forceinline__ void ld8h(const f16* p, float* o) {
  const h8 w = *(const h8*)p;
#pragma unroll
  for (int j = 0; j < 8; ++j) o[j] = (float)w[j];
}
__device__ __forceinline__ void st8h(f16* p, const float* v) {
  h8 w;
#pragma unroll
  for (int j = 0; j < 8; ++j) w[j] = (f16)v[j];
  *(h8*)p = w;
}
__device__ __forceinline__ void ld8f(const float* p, float* o) {
  const f32x4 a = *(const f32x4*)p, b = *(const f32x4*)(p + 4);
  o[0] = a[0]; o[1] = a[1]; o[2] = a[2]; o[3] = a[3]; o[4] = b[0]; o[5] = b[1]; o[6] = b[2]; o[7] = b[3];
}
__device__ __forceinline__ void adaln_phase(const Params& p, int bid, int nb, LAS unsigned char* lds, int tid) {
  LAS float* sc = (LAS float*)lds;
  LAS float* red = sc + NMOD * D;
  bool have = false;
  for (int item = bid; item < 2 * (D3 / 64); item += nb) {
    if (!have) {
      for (int i = tid; i < NMOD * D; i += NT) { const int r = i / D, k = i % D; const float cv = r < BATCH ? p.c[r * D + k] : p.c_ctx[k]; sc[i] = cv / (1.0f + __expf(-cv)); }
      have = true;
    }
    __syncthreads();
    const int l = item / (D3 / 64), j = (item % (D3 / 64)) * 64 + (tid & 63), kg = tid >> 6;
    const float* w = p.ada_w + (size_t)l * D * D3 + j;
    float acc[NMOD];
#pragma unroll
    for (int r = 0; r < NMOD; ++r) acc[r] = 0.f;
#pragma unroll 8
    for (int k = kg * (D / 8); k < (kg + 1) * (D / 8); ++k) {
      const float wv = w[(size_t)k * D3];
#pragma unroll
      for (int r = 0; r < NMOD; ++r) acc[r] = fmaf(sc[r * D + k], wv, acc[r]);
    }
#pragma unroll
    for (int r = 0; r < NMOD; ++r) red[(kg * NMOD + r) * 64 + (tid & 63)] = acc[r];
    __syncthreads();
    if (tid < NMOD * 64) {
      const int r = tid / 64, jj = tid & 63;
      float sum = p.ada_b[l * D3 + (item % (D3 / 64)) * 64 + jj];
#pragma unroll
      for (int q = 0; q < 8; ++q) sum += red[(q * NMOD + r) * 64 + jj];
      p.mod[((size_t)l * NMOD + r) * D3 + (item % (D3 / 64)) * 64 + jj] = sum;
    }
  }
}
__device__ __forceinline__ void normmod_phase(const Params& p, int l, int gw, int ngw, int lane, int m_first = 0) {
  for (int m = m_first + gw; m < M; m += ngw) {
    const float* src; int r;
    if (m < ML) { src = p.x + (size_t)m * D; r = m / SEQ; }
    else { src = (l == 0 ? p.ctx : p.XC1) + (size_t)(m - ML) * D; r = BATCH; }
    float v[D / 512][8]; float ss = 0.f;
#pragma unroll
    for (int q = 0; q < D / 512; ++q) {
      if (l == 1 && m < ML) ld8bf(p.X1b + (size_t)m * D + q * 512 + lane * 8, v[q]); else ld8f(src + q * 512 + lane * 8, v[q]);
#pragma unroll
      for (int j = 0; j < 8; ++j) ss = fmaf(v[q][j], v[q][j], ss); }
    const float rstd = 1.0f / sqrtf(xsum(ss, 64) / D + NORM_EPS);
    const float* md = p.mod + ((size_t)l * NMOD + r) * D3; const float* nw = p.norm_w + l * D;
#pragma unroll
    for (int q = 0; q < D / 512; ++q) { const int k0 = q * 512 + lane * 8; float nv[8], sh[8], sl[8], o[8];
      ld8f(nw + k0, nv); ld8f(md + k0, sh); ld8f(md + D + k0, sl);
#pragma unroll
      for (int j = 0; j < 8; ++j) o[j] = v[q][j] * rstd * nv[j] * (1.0f + sl[j]) + sh[j];
      st8bf(p.H + (size_t)m * D + k0, o); }
  }
}
__device__ __forceinline__ void final_phase(const Params& p, int gw, int ngw, int lane) {
  for (int m = gw; m < ML; m += ngw) {
    float* x = p.out + (size_t)m * D;
    float v[D / 512][8]; float ss = 0.f;
#pragma unroll
    for (int q = 0; q < D / 512; ++q) { ld8bf(p.X2b + (size_t)m * D + q * 512 + lane * 8, v[q]);
#pragma unroll
      for (int j = 0; j < 8; ++j) ss = fmaf(v[q][j], v[q][j], ss); }
    const float rstd = 1.0f / sqrtf(xsum(ss, 64) / D + NORM_EPS);
#pragma unroll
    for (int q = 0; q < D / 512; ++q) { const int k0 = q * 512 + lane * 8; float nv[8];
      ld8f(p.final_norm_w + k0, nv);
      f32x4 a = {v[q][0] * rstd * nv[0], v[q][1] * rstd * nv[1], v[q][2] * rstd * nv[2], v[q][3] * rstd * nv[3]};
      f32x4 b = {v[q][4] * rstd * nv[4], v[q][5] * rstd * nv[5], v[q][6] * rstd * nv[6], v[q][7] * rstd * nv[7]};
      *(f32x4*)(x + k0) = a; *(f32x4*)(x + k0 + 4) = b; }
  }
}
__device__ __forceinline__ void rwkv_out_phase(const Params& p, int bid, int nb, int tid) {
  for (long it = (long)bid * NT + tid; it < (long)M * 16 * 8; it += (long)nb * NT) {
    const long mh = it >> 3; const int sub = (int)(it & 7); const long m = mh >> 4; const int h = (int)(mh & 15);
    const int c = h * 64 + sub * 8; const long o1 = m * 1024 + c, o2 = (long)M * 1024 + o1;
    float y0[8], y1[8], vv[8];
    ld8h(p.Yd + o1, y0); ld8h(p.Yd + o2, y1); ld8h(p.V + o1, vv);
    const float bon = p.KN[mh];
    float s = 0.f;
#pragma unroll
    for (int j = 0; j < 8; ++j) { y0[j] += y1[j]; s += y0[j]; }
    const float mu = xsum(s, 8) * (1.0f / 64);
    float q = 0.f;
#pragma unroll
    for (int j = 0; j < 8; ++j) { y0[j] -= mu; q = fmaf(y0[j], y0[j], q); }
    const float rs = 1.0f / sqrtf(xsum(q, 8) * (1.0f / 64) + 64e-5f);
    float lw[8], lbv[8], gt[8], o[8];
    ld8f(p.rw_ln_w + c, lw); ld8f(p.rw_ln_b + c, lbv); ld8bf(p.G0 + m * 2048 + 1024 + c, gt);
#pragma unroll
    for (int j = 0; j < 8; ++j) o[j] = (y0[j] * rs * lw[j] + lbv[j] + bon * vv[j]) * gt[j];
    st8bf(p.YALL + m * 2048 + 1024 + c, o);
  }
}
__device__ __forceinline__ void hg_out_phase(const Params& p, int bid, int nb, int tid) {
  for (long it = (long)bid * NT + tid; it < (long)ML * 8 * 16; it += (long)nb * NT) {
    const long mh = it >> 4; const int sub = (int)(it & 15); const long m = mh >> 3; const int h = (int)(mh & 7);
    const int c = h * 128 + sub * 8; const long o1 = m * 1024 + c, o2 = (long)ML * 1024 + o1;
    float a[8], b2[8], w[8], gt[8], o[8];
    ld8h(p.O1d + o1, a); ld8h(p.O1d + o2, b2);
    float ss = 0.f;
#pragma unroll
    for (int j = 0; j < 8; ++j) { a[j] += b2[j]; ss = fmaf(a[j], a[j], ss); }
    const float rstd = 1.0f / sqrtf(xsum(ss, 16) * (1.0f / 128) + NORM_EPS);
    ld8f(p.hg_norm_w + sub * 8, w); ld8bf(p.G1 + m * 2048 + 1024 + c, gt);
#pragma unroll
    for (int j = 0; j < 8; ++j) o[j] = a[j] * rstd * w[j] * gt[j];
    st8bf(p.YALL + m * 2048 + 1024 + c, o);
  }
}
__device__ __forceinline__ void mla_prep_phase(const Params& p, int gw, int ngw, int lane) {
  for (int m = gw; m < M; m += ngw) {
    const bf16* z = p.CQKV + (size_t)m * 1088;
    float q[8], kv[8], w[8], o[8];
    ld8bf(z + lane * 8, q); ld8bf(z + 512 + lane * 8, kv);
    float sq = 0.f, sk = 0.f;
#pragma unroll
    for (int j = 0; j < 8; ++j) { sq = fmaf(q[j], q[j], sq); sk = fmaf(kv[j], kv[j], sk); }
    const float rq = 1.0f / sqrtf(xsum(sq, 64) * (1.0f / 512) + NORM_EPS), rk = 1.0f / sqrtf(xsum(sk, 64) * (1.0f / 512) + NORM_EPS);
    if (m < ML) { ld8f(p.mla_q_norm + lane * 8, w);
#pragma unroll
      for (int j = 0; j < 8; ++j) o[j] = q[j] * rq * w[j];
      st8bf(p.CQN + (size_t)m * 512 + lane * 8, o); }
    ld8f(p.mla_kv_norm + lane * 8, w);
#pragma unroll
    for (int j = 0; j < 8; ++j) o[j] = kv[j] * rk * w[j];
    st8bf(p.CKVN + (size_t)m * 512 + lane * 8, o);
    if (lane < 8) {
      float x[8]; ld8bf(z + 1024 + lane * 8, x);
      if (m < ML) {
        const float* rt = p.ROPE + ((size_t)(m % SEQ) * 32 + lane * 4) * 2;
        float cs[8]; ld8f(rt, cs);
#pragma unroll
        for (int j = 0; j < 4; ++j) { const float x0 = x[2 * j], x1 = x[2 * j + 1]; x[2 * j] = x0 * cs[2 * j] - x1 * cs[2 * j + 1]; x[2 * j + 1] = x0 * cs[2 * j + 1] + x1 * cs[2 * j]; }
      }
      st8bf(p.KPE + (size_t)kvrow(m) * 64 + lane * 8, x);
    }
  }
}


__device__ __forceinline__ void shift8(const Params& p, int row, int c, float* out) {
  const bool lat = row < ML; const int t = lat ? row % SEQ : (row - ML) % CTX; const int tn = lat ? SEQ : CTX;
  float u[8], pv[8], nx[8], mp[8], mn[8];
  ld8bf(p.U0 + (size_t)row * 3328 + c, u);
  if (t > 0) ld8bf(p.U0 + (size_t)(row - 1) * 3328 + c, pv); else {
#pragma unroll
    for (int j = 0; j < 8; ++j) pv[j] = 0.f; }
  if (t < tn - 1) ld8bf(p.U0 + (size_t)(row + 1) * 3328 + c, nx); else {
#pragma unroll
    for (int j = 0; j < 8; ++j) nx[j] = 0.f; }
  ld8f(p.rw_mu + c, mp); ld8f(p.rw_mu + 3328 + c, mn);
#pragma unroll
  for (int j = 0; j < 8; ++j) out[j] = u[j] + mp[j] * (pv[j] - u[j]) + mn[j] * (nx[j] - u[j]);
}
__device__ __forceinline__ void rwkv_prep_phase(const Params& p, int bid, int nb, int tid) {
  for (long it = (long)bid * NT + tid; it < 4096L * 32; it += (long)nb * NT) {
    const int n = (int)(it >> 5), kg = (int)(it & 31), blk = n >> 10, c = n & 1023;
    float v[8];
#pragma unroll
    for (int j = 0; j < 8; ++j) v[j] = 0.f;
    if ((kg >> 3) == blk) {
      const float* W = (blk < 2 ? p.rw_w2 : p.rw_a2) + (size_t)(blk & 1) * 64 * 1024;
#pragma unroll
      for (int j = 0; j < 8; ++j) v[j] = W[(size_t)((kg & 7) * 8 + j) * 1024 + c];
    }
    st8bf(p.Btm + (size_t)n * 256 + kg * 8, v);
  }
}
__device__ __forceinline__ void rwkv_lr_phase(const Params& p, int bid, int nb, int tid) {
  for (long it = (long)bid * NT + tid; it < (long)M * 32; it += (long)nb * NT) {
    const int m = (int)(it >> 5), g = (int)(it & 31);
    float v[8]; shift8(p, m, 3072 + g * 8, v);
    if (g < 16) {
#pragma unroll
      for (int j = 0; j < 8; ++j) v[j] = 1.0f - 2.0f * __builtin_amdgcn_rcpf(1.0f + __expf(2.0f * v[j]));
    }
    st8bf(p.LRb + (size_t)m * 256 + g * 8, v);
  }
}

__device__ __forceinline__ void rwkv_fin_phase(const Params& p, int bid, int nb, int tid) {
  constexpr int RS = 8;
  for (long it = (long)bid * NT + tid; it < (long)(M / RS) * 16 * 8; it += (long)nb * NT) {
    const int sub = (int)(it & 7); const long sh = it >> 3; const int h = (int)(sh & 15); const int m0 = (int)(sh >> 4) * RS;
    const int c = h * 64 + sub * 8;
    float kkw[8], ka[8], rk[8], mp[3][8], mn[3][8];
    ld8f(p.rw_k_k + c, kkw); ld8f(p.rw_k_a + c, ka); ld8f(p.rw_r_k + c, rk);
#pragma unroll
    for (int q = 0; q < 3; ++q) { ld8f(p.rw_mu + q * 1024 + c, mp[q]); ld8f(p.rw_mu + 3328 + q * 1024 + c, mn[q]); }
    const bool lat = m0 < ML; const int t0 = lat ? m0 % SEQ : (m0 - ML) % CTX; const int tn = lat ? SEQ : CTX;
    float pv[3][8], cu[3][8], nx[3][8];
#pragma unroll
    for (int q = 0; q < 3; ++q) {
      if (t0 > 0) ld8bf(p.U0 + (size_t)(m0 - 1) * 3328 + q * 1024 + c, pv[q]); else {
#pragma unroll
        for (int j = 0; j < 8; ++j) pv[q][j] = 0.f; }
      ld8bf(p.U0 + (size_t)m0 * 3328 + q * 1024 + c, cu[q]);
    }
#pragma unroll
    for (int rr = 0; rr < RS; ++rr) {
      const int m = m0 + rr; const size_t o1 = (size_t)m * 1024 + c;
#pragma unroll
      for (int q = 0; q < 3; ++q) {
        if (t0 + rr < tn - 1) ld8bf(p.U0 + (size_t)(m + 1) * 3328 + q * 1024 + c, nx[q]); else {
#pragma unroll
          for (int j = 0; j < 8; ++j) nx[q][j] = 0.f; }
      }
      float r[8], k[8], v[8];
#pragma unroll
      for (int j = 0; j < 8; ++j) {
        r[j] = cu[0][j] + mp[0][j] * (pv[0][j] - cu[0][j]) + mn[0][j] * (nx[0][j] - cu[0][j]);
        k[j] = cu[1][j] + mp[1][j] * (pv[1][j] - cu[1][j]) + mn[1][j] * (nx[1][j] - cu[1][j]);
        v[j] = cu[2][j] + mp[2][j] * (pv[2][j] - cu[2][j]) + mn[2][j] * (nx[2][j] - cu[2][j]);
      }
      float kw[8], ss = 0.f;
#pragma unroll
      for (int j = 0; j < 8; ++j) { kw[j] = kkw[j] * k[j]; ss = fmaf(kw[j], kw[j], ss); }
      const float kn = 1.0f / fmaxf(sqrtf(xsum(ss, 8)), 1e-12f);
      float nk[8];
#pragma unroll
      for (int j = 0; j < 8; ++j) { kw[j] *= kn; nk[j] = -kw[j]; }
      st8h(p.R + o1, r); st8h(p.V + o1, v); st8h(p.KK + o1, nk);
      float bon = 0.f;
#pragma unroll
      for (int d = 0; d < 2; ++d) {
        const size_t o2 = (size_t)d * M * 1024 + o1;
        float a[8], kd[8], bb[8];
        ld8h(p.BB + o2, a);
#pragma unroll
        for (int j = 0; j < 8; ++j) { kd[j] = k[j] * (1.0f + (a[j] - 1.0f) * ka[j]); bb[j] = kw[j] * a[j]; bon = fmaf(r[j] * kd[j], rk[j], bon); }
        st8h(p.KD + o2, kd); st8h(p.BB + o2, bb);
      }
      bon = xsum(bon, 8);
      if (sub == 0) p.KN[(size_t)m * 16 + h] = bon;
#pragma unroll
      for (int q = 0; q < 3; ++q)
#pragma unroll
        for (int j = 0; j < 8; ++j) { pv[q][j] = cu[q][j]; cu[q][j] = nx[q][j]; }
    }
  }
}
struct GEpiTermsP { const float *rw_w0, *rw_a0; f16 *DL, *BB; };
struct GEpiTerms {
  static constexpr bool PERM = true, AFTER_DRAIN = false;
  GEpiTermsP p;
  __device__ __forceinline__ void operator()(const f32x4 (&acc)[2][2][4][2], const pg8::Unit& u, int wr, int wc, int fr, int fq) const {
    const int blk = u.pn >> 2, d = blk & 1, cb = (u.pn & 3) * 256;
    const size_t doff = (size_t)d * M * 1024;
#pragma unroll
    for (int bj = 0; bj < 2; ++bj) {
      const int c = cb + bj * 128 + wc * 32 + 8 * fq;
      if (blk < 2) {
        float w0[8]; ld8f(p.rw_w0 + d * 1024 + c, w0);
#pragma unroll
        for (int ai = 0; ai < 2; ++ai)
#pragma unroll
          for (int m = 0; m < 4; ++m) {
            const int row = u.pm * 256 + ai * 128 + wr * 64 + m * 16 + fr;
            float o[8];
#pragma unroll
            for (int j = 0; j < 8; ++j) {
              const float w = w0[j] + (j < 4 ? acc[ai][bj][m][0][j] : acc[ai][bj][m][1][j - 4]);
              const float e = 0.60653065971263342f * __builtin_amdgcn_rcpf(1.0f + __expf(-w));
              o[j] = __expf(-e) - 1.0f;
            }
            st8h(p.DL + doff + (size_t)row * 1024 + c, o);
          }
      } else {
        float a0[8]; ld8f(p.rw_a0 + d * 1024 + c, a0);
#pragma unroll
        for (int ai = 0; ai < 2; ++ai)
#pragma unroll
          for (int m = 0; m < 4; ++m) {
            const int row = u.pm * 256 + ai * 128 + wr * 64 + m * 16 + fr;
            float o[8];
#pragma unroll
            for (int j = 0; j < 8; ++j) o[j] = __builtin_amdgcn_rcpf(1.0f + __expf(-(a0[j] + (j < 4 ? acc[ai][bj][m][0][j] : acc[ai][bj][m][1][j - 4]))));
            st8h(p.BB + doff + (size_t)row * 1024 + c, o);
          }
      }
    }
  }
};


__device__ __forceinline__ hb8 join4z(hb4 lo) { return (hb8){lo[0], lo[1], lo[2], lo[3], 0, 0, 0, 0}; }
__device__ __forceinline__ void rwkv_chunk_phase(const Params& p, int bid, int nb, LAS unsigned char* lds, const int wave_s) {
  constexpr int NCH = (CTX + SEQ) / RC;
  for (int unit = bid; unit < 2 * BATCH * 16; unit += nb) {
    const int tid = fresh_tid(wave_s), lane = tid & 63, l15 = lane & 15, g4 = lane >> 4;
    const int h = unit % 16, b = (unit / 16) % BATCH, d = unit / (16 * BATCH);
    LAS float* NBF = (LAS float*)(lds + RC_NBF);
    __syncthreads();
    for (int i = tid; i < (3 * RC_IMG + 2 * RC_MAT) / 4; i += NT) ((LAS unsigned*)lds)[i] = 0u;
    const int ka = 32 * (wave_s & 1) + (lane & 31), hs = lane >> 5;
    const f16* pDL = p.DL + (size_t)d * M * 1024 + h * 64 + ka; const f16* pKD = p.KD + (size_t)d * M * 1024 + h * 64 + ka; const f16* pBB = p.BB + (size_t)d * M * 1024 + h * 64 + ka;
    const f16* pKK = p.KK + h * 64 + ka; const f16* pR = p.R + h * 64 + ka; const f16* pV = p.V + h * 64 + ka;
    f32x4 ST[4];
#pragma unroll
    for (int t = 0; t < 4; ++t) ST[t] = (f32x4){0.f, 0.f, 0.f, 0.f};
    f16 ndl[8], nkd[8], nbb[8], nkk[8], nr[8], nv[8];
    const long rstep = d ? -1024 : 1024;
    auto pload = [&](int c) {
      const long o0 = seq_row(d, b, c * RC + 8 * hs) * 1024;
#pragma unroll
      for (int q = 0; q < 8; ++q) { const long o = o0 + q * rstep; ndl[q] = pDL[o]; nkd[q] = pKD[o]; nbb[q] = pBB[o]; nkk[q] = pKK[o]; nr[q] = pR[o]; nv[q] = pV[o]; }
    };
    auto prepA = [&](int c) {
      LAS unsigned char* im = lds + (c % 3) * RC_IMG;
      LAS bf16* AT = (LAS bf16*)(im + RC_AT); LAS bf16* RT = (LAS bf16*)(im + RC_RT); LAS bf16* BT = (LAS bf16*)(im + RC_BT); LAS bf16* KT = (LAS bf16*)(im + RC_KT);
      LAS bf16* KH = (LAS bf16*)(im + RC_KH); LAS bf16* VT = (LAS bf16*)(im + RC_VT); LAS bf16* BH = (LAS bf16*)(im + RC_BH); LAS float* PC = (LAS float*)(im + RC_PC);
      float pr[8], av[8], bv[8], kv[8], rv[8], vv[8];
      float run = 1.f;
#pragma unroll
      for (int q = 0; q < 8; ++q) { run *= 1.0f + (float)ndl[q]; pr[q] = run; av[q] = (float)nkk[q]; bv[q] = (float)nbb[q]; kv[q] = (float)nkd[q]; rv[q] = (float)nr[q]; vv[q] = (float)nv[q]; }
      __builtin_amdgcn_sched_barrier(0);
      pload(c + 1 < NCH ? c + 1 : NCH - 1);
      __builtin_amdgcn_sched_barrier(0);
      const float oth = __shfl_xor(run, 32);
      const float pre = hs ? oth : 1.f, tot = run * oth;
      unsigned bh[4], kh[4], vt[4];
#pragma unroll
      for (int q = 0; q < 8; ++q) {
        const int i = 8 * hs + q;
        const float Pi = pre * pr[q], Pm = q ? pre * pr[q - 1] : pre, inv = __builtin_amdgcn_rcpf(Pi);
        AT[i * RC_LD + ka] = f2bf(av[q] * Pm); RT[i * RC_LD + ka] = f2bf(rv[q] * Pi);
        bv[q] *= inv; kv[q] *= inv;
        BT[i * RC_LD + ka] = f2bf(bv[q]); KT[i * RC_LD + ka] = f2bf(kv[q]);
      }
#pragma unroll
      for (int q = 0; q < 4; ++q) { bh[q] = cvt2(bv[2 * q] * tot, bv[2 * q + 1] * tot); kh[q] = cvt2(kv[2 * q] * tot, kv[2 * q + 1] * tot); vt[q] = cvt2(vv[2 * q], vv[2 * q + 1]); }
      *(LAS u32x4*)(BH + ka * 16 + 8 * hs) = (u32x4){bh[0], bh[1], bh[2], bh[3]};
      *(LAS u32x4*)(KH + ka * RC_LDJ + 8 * hs) = (u32x4){kh[0], kh[1], kh[2], kh[3]};
      *(LAS u32x4*)(VT + ka * RC_LDJ + 8 * hs) = (u32x4){vt[0], vt[1], vt[2], vt[3]};
      if (hs == 0) PC[ka] = tot;
    };
    auto prepB = [&](int c) {
      LAS unsigned char* im = lds + (c % 3) * RC_IMG; LAS unsigned char* mt = lds + RC_MAT0 + (c & 1) * RC_MAT;
      LAS bf16* NKT = (LAS bf16*)(mt + RC_NKT); LAS bf16* MKT = (LAS bf16*)(mt + RC_MKT); LAS bf16* TT = (LAS bf16*)(mt + RC_TT); LAS bf16* MBT = (LAS bf16*)(mt + RC_MBT);
      const LAS bf16* AT = (const LAS bf16*)(im + RC_AT); const LAS bf16* RT = (const LAS bf16*)(im + RC_RT); const LAS bf16* BT = (const LAS bf16*)(im + RC_BT); const LAS bf16* KT = (const LAS bf16*)(im + RC_KT);
      const int fo = l15 * RC_LD + g4 * 8;
      if (wave_s == 4) {
        f32x4 D0 = {0.f, 0.f, 0.f, 0.f}, D1 = D0, D2 = D0;
#pragma unroll
        for (int ks = 0; ks < 2; ++ks) {
          const hb8 fa = *(const LAS hb8*)(AT + fo + ks * 32), fr = *(const LAS hb8*)(RT + fo + ks * 32), fb = *(const LAS hb8*)(BT + fo + ks * 32), fk = *(const LAS hb8*)(KT + fo + ks * 32);
          D0 = __builtin_amdgcn_mfma_f32_16x16x32_bf16(fa, fk, D0, 0, 0, 0);
          D1 = __builtin_amdgcn_mfma_f32_16x16x32_bf16(fr, fb, D1, 0, 0, 0);
          D2 = __builtin_amdgcn_mfma_f32_16x16x32_bf16(fr, fk, D2, 0, 0, 0);
        }
#pragma unroll
        for (int r = 0; r < 4; ++r) {
          const int i = 4 * g4 + r;
          NKT[i * RC_LDJ + l15] = f2bf(l15 < i ? D0[r] : 0.f);
          MBT[i * 16 + l15] = f2bf(l15 <= i ? D1[r] : 0.f);
          MKT[i * RC_LDJ + l15] = f2bf(l15 <= i ? D2[r] : 0.f);
        }
      } else {
        f32x4 Dm = {0.f, 0.f, 0.f, 0.f};
#pragma unroll
        for (int ks = 0; ks < 2; ++ks) Dm = __builtin_amdgcn_mfma_f32_16x16x32_bf16(*(const LAS hb8*)(AT + fo + ks * 32), *(const LAS hb8*)(BT + fo + ks * 32), Dm, 0, 0, 0);
#pragma unroll
        for (int r = 0; r < 4; ++r) { const int i = 4 * g4 + r; NBF[i * 20 + l15] = (l15 < i) ? Dm[r] : 0.f; }
        asm volatile("s_waitcnt lgkmcnt(0)" ::: "memory");
        f32x4 nrow[16][4];
#pragma unroll
        for (int i = 1; i < 16; ++i)
#pragma unroll
          for (int q4 = 0; q4 < 4; ++q4) if (4 * q4 < i) nrow[i][q4] = *(const LAS f32x4*)(NBF + i * 20 + 4 * q4);
        __builtin_amdgcn_sched_barrier(0);
        float t[16];
#pragma unroll
        for (int i = 0; i < 16; ++i) {
          float acc = (i == l15) ? 1.f : 0.f;
#pragma unroll
          for (int j = 0; j < i; ++j) acc = fmaf(t[j], nrow[i][j >> 2][j & 3], acc);
          t[i] = acc;
        }
        if (g4 == 0) {
#pragma unroll
          for (int i = 0; i < 16; ++i) TT[i * 16 + l15] = f2bf(t[i]);
        }
      }
    };
    auto stage2 = [&](int c) {
      LAS unsigned char* im = lds + (c % 3) * RC_IMG; LAS unsigned char* mt = lds + RC_MAT0 + (c & 1) * RC_MAT;
      const LAS bf16* AT = (const LAS bf16*)(im + RC_AT); const LAS bf16* RT = (const LAS bf16*)(im + RC_RT);
      const LAS bf16* KH = (const LAS bf16*)(im + RC_KH); const LAS bf16* VT = (const LAS bf16*)(im + RC_VT); const LAS bf16* BH = (const LAS bf16*)(im + RC_BH); const LAS float* PC = (const LAS float*)(im + RC_PC);
      const LAS bf16* NKT = (const LAS bf16*)(mt + RC_NKT); const LAS bf16* MKT = (const LAS bf16*)(mt + RC_MKT); const LAS bf16* TT = (const LAS bf16*)(mt + RC_TT); const LAS bf16* MBT = (const LAS bf16*)(mt + RC_MBT);
      const int vrow = wave_s * 16 + l15;
      const hb8 vfr = *(const LAS hb8*)(VT + vrow * RC_LDJ + g4 * 8);
      f32x4 Xt = {0.f, 0.f, 0.f, 0.f}, Yt = Xt;
#pragma unroll
      for (int ks = 0; ks < 2; ++ks) {
        const hb8 sb = pack_acc(ST[2 * ks], ST[2 * ks + 1]);
        const hb8 aa = join4(*(const LAS hb4*)(AT + l15 * RC_LD + ks * 32 + 4 * g4), *(const LAS hb4*)(AT + l15 * RC_LD + ks * 32 + 16 + 4 * g4));
        const hb8 ra = join4(*(const LAS hb4*)(RT + l15 * RC_LD + ks * 32 + 4 * g4), *(const LAS hb4*)(RT + l15 * RC_LD + ks * 32 + 16 + 4 * g4));
        Xt = __builtin_amdgcn_mfma_f32_16x16x32_bf16(aa, sb, Xt, 0, 0, 0);
        Yt = __builtin_amdgcn_mfma_f32_16x16x32_bf16(ra, sb, Yt, 0, 0, 0);
      }
      const f32x4 Zr = {0.f, 0.f, 0.f, 0.f};
      Xt = __builtin_amdgcn_mfma_f32_16x16x32_bf16(*(const LAS hb8*)(NKT + l15 * RC_LDJ + g4 * 8), vfr, Xt, 0, 0, 0);
      const f32x4 Sg = __builtin_amdgcn_mfma_f32_16x16x32_bf16(join4z(*(const LAS hb4*)(TT + l15 * 16 + 4 * g4)), pack_acc(Xt, Zr), Zr, 0, 0, 0);
      const hb8 sgb = pack_acc(Sg, Zr);
      Yt = __builtin_amdgcn_mfma_f32_16x16x32_bf16(join4z(*(const LAS hb4*)(MBT + l15 * 16 + 4 * g4)), sgb, Yt, 0, 0, 0);
      Yt = __builtin_amdgcn_mfma_f32_16x16x32_bf16(*(const LAS hb8*)(MKT + l15 * RC_LDJ + g4 * 8), vfr, Yt, 0, 0, 0);
#pragma unroll
      for (int t = 0; t < 4; ++t) {
        const f32x4 pc = *(const LAS f32x4*)(PC + 16 * t + 4 * g4);
        f32x4 acc = ST[t] * pc;
        acc = __builtin_amdgcn_mfma_f32_16x16x32_bf16(join4z(*(const LAS hb4*)(BH + (16 * t + l15) * 16 + 4 * g4)), sgb, acc, 0, 0, 0);
        ST[t] = __builtin_amdgcn_mfma_f32_16x16x32_bf16(*(const LAS hb8*)(KH + (16 * t + l15) * RC_LDJ + g4 * 8), vfr, acc, 0, 0, 0);
      }
      f16* yo = p.Yd + (size_t)d * M * 1024 + h * 64 + vrow + seq_row(d, b, c * RC + 4 * g4) * 1024;
#pragma unroll
      for (int r = 0; r < 4; ++r) yo[r * rstep] = (f16)Yt[r];
    };
    if (wave_s >= 6) pload(0);
    __syncthreads();
    if (wave_s < 4) {
      for (int c = -2; c < NCH; ++c) { if (c >= 0) stage2(c); WG_BAR_LDS(); }
    } else if (wave_s < 6) {
      for (int c = -2; c < NCH; ++c) { if (c + 1 >= 0 && c + 1 < NCH) prepB(c + 1); WG_BAR_LDS(); }
    } else {
      for (int c = -2; c < NCH; ++c) { if (c + 2 < NCH) prepA(c + 2); WG_BAR_LDS(); }
    }
  }
}


#define XB_TMO      128
#define XB_XCNT(j)  (256  + 64 * (j))
#define XB_XSUB(j)  (1280 + 64 * (j))
#define XB_XGEN(j)  (2304 + 64 * (j))
#define XB_TOP      3328
#define XB_TOPGEN   3392
#define XCD_BAR_WORDS 3456
#define NA_CTR_WORD 3600
#define XB_SPIN_CAP (1u << 18)
__device__ __forceinline__ unsigned xb_ld(unsigned* p)              { return __hip_atomic_load(p, __ATOMIC_RELAXED, __HIP_MEMORY_SCOPE_AGENT); }
__device__ __forceinline__ unsigned xb_add(unsigned* p, unsigned v) { return __hip_atomic_fetch_add(p, v, __ATOMIC_RELAXED, __HIP_MEMORY_SCOPE_AGENT); }
__device__ __forceinline__ unsigned xb_xcc_id() { return (unsigned)__builtin_amdgcn_s_getreg((3 << 11) | 20) & 0xFu; }
#define XB_SPIN(cond, bar) do { unsigned _sp = 0; while (cond) { __builtin_amdgcn_s_sleep(1); \
    if ((++_sp & 255u) == 0u) { if (xb_ld(&(bar)[XB_TMO])) break; if (_sp > XB_SPIN_CAP) { atomicAdd(&(bar)[XB_TMO], 1u); break; } } } } while (0)
struct XcdBarrier { unsigned* bar; unsigned x; volatile LAS unsigned* st; };
__device__ __forceinline__ XcdBarrier xcd_barrier_post(unsigned* bar, volatile LAS unsigned* st, bool t0) {
  XcdBarrier b; b.bar = bar; b.x = xb_xcc_id(); b.st = st;
  if (t0) (void)xb_add(&bar[XB_XCNT(b.x)], 1u);
  return b;
}
__device__ __forceinline__ void xcd_barrier_complete(unsigned* bar, unsigned x, unsigned& nloc, unsigned& nx) {
  const unsigned G = gridDim.x * gridDim.y * gridDim.z;
  unsigned sum, cnt, mine, sp = 0u;
  for (;;) {
    sum = 0u; cnt = 0u; mine = 0u;
#pragma unroll
    for (unsigned j = 0; j < 16; ++j) { const unsigned c = xb_ld(&bar[XB_XCNT(j)]); sum += c; cnt += (c > 0u) ? 1u : 0u; mine = (j == x) ? c : mine; }
    if (sum == G) break;
    __builtin_amdgcn_s_sleep(1);
    if ((++sp & 255u) == 0u) { if (xb_ld(&bar[XB_TMO])) break; if (sp > XB_SPIN_CAP) { atomicAdd(&bar[XB_TMO], 1u); break; } }
  }
  nloc = mine > 0u ? mine : 1u; nx = cnt > 0u ? cnt : 1u;
}
__device__ __forceinline__ void xcd_barrier(const XcdBarrier& b, bool t0) {
  asm volatile("s_waitcnt vmcnt(0)" ::: "memory");
  __syncthreads();
  if (t0) {
    unsigned* bar = b.bar;
    __builtin_amdgcn_s_waitcnt(0);
    unsigned nloc = b.st[0], nx = b.st[1];
    if (nloc == 0u) { xcd_barrier_complete(bar, b.x, nloc, nx); b.st[0] = nloc; b.st[1] = nx; }
    const unsigned old = xb_add(&bar[XB_XSUB(b.x)], 1u);
    const unsigned gen = old / nloc;
    if (old + 1u == (gen + 1u) * nloc) {
      __builtin_amdgcn_fence(__ATOMIC_RELEASE, "agent");
      asm volatile("s_waitcnt vmcnt(0)" ::: "memory");
      const unsigned og = xb_add(&bar[XB_TOP], 1u);
      const unsigned tg = og / nx;
      if (og + 1u == (tg + 1u) * nx) xb_add(&bar[XB_TOPGEN], 1u);
      else XB_SPIN(xb_ld(&bar[XB_TOPGEN]) == tg, bar);
      __builtin_amdgcn_fence(__ATOMIC_ACQUIRE, "agent");
      xb_add(&bar[XB_XGEN(b.x)], 1u);
      asm volatile("s_waitcnt vmcnt(0)" ::: "memory");
    } else {
      XB_SPIN(xb_ld(&bar[XB_XGEN(b.x)]) == gen, bar);
      __builtin_amdgcn_fence(__ATOMIC_ACQUIRE, "agent");
      asm volatile("s_waitcnt vmcnt(0)" ::: "memory");
    }
  }
  __syncthreads();
}

struct Out0Order {
  pg8::StaticOrder sl; int extra, c;
  __device__ void init(int G_, int c_) { sl.init(ML, D, G_, c_); extra = (M / 256) * (D / 256) - G_; c = c_; }
  __device__ bool next(int i, pg8::Unit& u) const {
    const bool two = c < extra;
    if (i == 0 && two) { u.pm = ML / 256 + c % (MC / 256); u.pn = c / (MC / 256); return true; }
    if (i == (two ? 1 : 0)) { sl.map(c, u); return true; }
    return false;
  }
  __device__ __forceinline__ void a_ready(const pg8::Unit&) const {}
  __device__ __forceinline__ void done(const pg8::Unit&) const {}
};
struct GEpiOut0Fused {
  static constexpr bool PERM = true, AFTER_DRAIN = true;
  const float *x, *ctx, *mod, *nw; float* XC1; bf16 *X1b, *H; float* slots; XcdBarrier xb;
  __device__ __forceinline__ void operator()(const f32x4 (&acc)[2][2][4][2], const pg8::Unit& u, int wr, int wc, int fr, int fq) const {
    const int rbase = u.pm * 256 - ML;
    const float* gate = mod + ((size_t)0 * NMOD + BATCH) * D3 + 2 * D;
    const int col0 = u.pn * 256 + wc * 32 + 8 * fq;
#pragma unroll
    for (int bj = 0; bj < 2; ++bj) {
      const f32x4 g0 = *(const f32x4*)(gate + col0 + bj * 128), g1 = *(const f32x4*)(gate + col0 + bj * 128 + 4);
#pragma unroll
      for (int ai = 0; ai < 2; ++ai)
#pragma unroll
        for (int m = 0; m < 4; ++m) {
          const size_t off = (size_t)(rbase + wr * 64 + fr + ai * 128 + m * 16) * D + col0 + bj * 128;
          *(f32x4*)(XC1 + off) = *(const f32x4*)(ctx + off) + g0 * acc[ai][bj][m][0];
          *(f32x4*)(XC1 + off + 4) = *(const f32x4*)(ctx + off + 4) + g1 * acc[ai][bj][m][1];
        }
    }
  }
  __device__ __forceinline__ void fused(f32x4 (&acc)[2][2][4][2], const pg8::Unit& u, int wr, int wc, int fr, int fq, LAS unsigned char* lds, int wid, int lane) const {
    const int rowt = u.pm * 256, r_mod = rowt / SEQ;
    const float* gate = mod + ((size_t)0 * NMOD + r_mod) * D3 + 2 * D;
    const int col0 = u.pn * 256 + wc * 32 + 8 * fq;
    LAS float* P = (LAS float*)lds; LAS float* S = (LAS float*)(lds + 8192);
    {
      f32x4 g[2][2];
#pragma unroll
      for (int bj = 0; bj < 2; ++bj)
#pragma unroll
        for (int n = 0; n < 2; ++n) g[bj][n] = *(const f32x4*)(gate + col0 + bj * 128 + n * 4);
#pragma unroll
      for (int ai = 0; ai < 2; ++ai)
#pragma unroll
        for (int m = 0; m < 4; ++m) {
          const int r = ai * 128 + wr * 64 + m * 16 + fr;
          const size_t off = (size_t)(rowt + r) * D + col0;
          float ss = 0.f;
#pragma unroll
          for (int bj = 0; bj < 2; ++bj) {
            const f32x4 o0 = *(const f32x4*)(x + off + bj * 128) + g[bj][0] * acc[ai][bj][m][0], o1 = *(const f32x4*)(x + off + bj * 128 + 4) + g[bj][1] * acc[ai][bj][m][1];
            acc[ai][bj][m][0] = o0; acc[ai][bj][m][1] = o1;
            *(u32x4*)(X1b + off + bj * 128) = pack8<false>(o0, o1);
            ss += (o0[0] * o0[0] + o0[1] * o0[1]) + (o0[2] * o0[2] + o0[3] * o0[3]) + (o1[0] * o1[0] + o1[1] * o1[1]) + (o1[2] * o1[2] + o1[3] * o1[3]);
          }
          ss += __shfl_xor(ss, 16); ss += __shfl_xor(ss, 32);
          if (fq == 0) P[r * 4 + wc] = ss;
          if (m & 1) asm volatile("" ::: "memory");
        }
    }
    asm volatile("s_waitcnt lgkmcnt(0)" ::: "memory"); __builtin_amdgcn_s_barrier(); asm volatile("" ::: "memory");
    const int row = wid * 32 + (lane & 31);
    if (lane < 32) slots[(size_t)(rowt + row) * 8 + u.pn] = (P[row * 4] + P[row * 4 + 1]) + (P[row * 4 + 2] + P[row * 4 + 3]);
    xcd_barrier(xb, wid == 0 && lane == 0);
    if (lane < 32) {
      const f32x4 a = *(const f32x4*)(slots + (size_t)(rowt + row) * 8), b = *(const f32x4*)(slots + (size_t)(rowt + row) * 8 + 4);
      const float t = ((a[0] + a[1]) + (a[2] + a[3])) + ((b[0] + b[1]) + (b[2] + b[3]));
      S[row] = 1.0f / sqrtf(t / D + NORM_EPS);
    }
    asm volatile("s_waitcnt lgkmcnt(0)" ::: "memory"); __builtin_amdgcn_s_barrier(); asm volatile("" ::: "memory");
    const float* md = mod + ((size_t)1 * NMOD + r_mod) * D3; const float* nwp = nw + D;
#pragma unroll
    for (int bj = 0; bj < 2; ++bj) {
      f32x4 mul[2], add[2];
#pragma unroll
      for (int n = 0; n < 2; ++n) {
        const int c = col0 + bj * 128 + n * 4;
        mul[n] = *(const f32x4*)(nwp + c) * ((f32x4){1.f, 1.f, 1.f, 1.f} + *(const f32x4*)(md + D + c)); add[n] = *(const f32x4*)(md + c);
      }
#pragma unroll
      for (int ai = 0; ai < 2; ++ai)
#pragma unroll
        for (int m = 0; m < 4; ++m) {
          const int r = ai * 128 + wr * 64 + m * 16 + fr;
          const float rs = S[r];
          *(u32x4*)(H + (size_t)(rowt + r) * D + col0 + bj * 128) = pack8<false>(acc[ai][bj][m][0] * rs * mul[0] + add[0], acc[ai][bj][m][1] * rs * mul[1] + add[1]);
        }
    }
  }
};
struct GEpiOutFinal {
  static constexpr bool PERM = true, AFTER_DRAIN = true;
  const float *mod, *fw; const bf16* X1b; float *out, *slots; XcdBarrier xb;
  __device__ __forceinline__ void operator()(const f32x4 (&)[2][2][4][2], const pg8::Unit&, int, int, int, int) const {}
  __device__ __forceinline__ void fused(f32x4 (&acc)[2][2][4][2], const pg8::Unit& u, int wr, int wc, int fr, int fq, LAS unsigned char* lds, int wid, int lane) const {
    const int rowt = u.pm * 256;
    const float* gate = mod + ((size_t)1 * NMOD + rowt / SEQ) * D3 + 2 * D;
    const int col0 = u.pn * 256 + wc * 32 + 8 * fq;
    LAS float* P = (LAS float*)lds;
    LAS float* S = (LAS float*)(lds + 8192);
    {
      f32x4 g[2][2];
#pragma unroll
      for (int bj = 0; bj < 2; ++bj)
#pragma unroll
        for (int n = 0; n < 2; ++n) g[bj][n] = *(const f32x4*)(gate + col0 + bj * 128 + n * 4);
#pragma unroll
      for (int ai = 0; ai < 2; ++ai)
#pragma unroll
        for (int m = 0; m < 4; ++m) {
          const int r = ai * 128 + wr * 64 + m * 16 + fr;
          const size_t off = (size_t)(rowt + r) * D + col0;
          float ss = 0.f;
#pragma unroll
          for (int bj = 0; bj < 2; ++bj) {
            const u32x4 w = *(const u32x4*)(X1b + off + bj * 128);
            const f32x4 s0 = {__uint_as_float(w.x << 16), __uint_as_float(w.x & 0xffff0000u), __uint_as_float(w.y << 16), __uint_as_float(w.y & 0xffff0000u)};
            const f32x4 s1 = {__uint_as_float(w.z << 16), __uint_as_float(w.z & 0xffff0000u), __uint_as_float(w.w << 16), __uint_as_float(w.w & 0xffff0000u)};
            const f32x4 o0 = s0 + g[bj][0] * acc[ai][bj][m][0], o1 = s1 + g[bj][1] * acc[ai][bj][m][1];
            acc[ai][bj][m][0] = o0; acc[ai][bj][m][1] = o1;
            ss += (o0[0] * o0[0] + o0[1] * o0[1]) + (o0[2] * o0[2] + o0[3] * o0[3]) + (o1[0] * o1[0] + o1[1] * o1[1]) + (o1[2] * o1[2] + o1[3] * o1[3]);
          }
          ss += __shfl_xor(ss, 16); ss += __shfl_xor(ss, 32);
          if (fq == 0) P[r * 4 + wc] = ss;
          if (m & 1) asm volatile("" ::: "memory");
        }
    }
    asm volatile("s_waitcnt lgkmcnt(0)" ::: "memory"); __builtin_amdgcn_s_barrier(); asm volatile("" ::: "memory");
    const int row = wid * 32 + (lane & 31);
    if (lane < 32) slots[(size_t)(rowt + row) * 8 + u.pn] = (P[row * 4] + P[row * 4 + 1]) + (P[row * 4 + 2] + P[row * 4 + 3]);
    xcd_barrier(xb, wid == 0 && lane == 0);
    if (lane < 32) {
      const f32x4 a = *(const f32x4*)(slots + (size_t)(rowt + row) * 8), b = *(const f32x4*)(slots + (size_t)(rowt + row) * 8 + 4);
      const float t = ((a[0] + a[1]) + (a[2] + a[3])) + ((b[0] + b[1]) + (b[2] + b[3]));
      S[row] = 1.0f / sqrtf(t / D + NORM_EPS);
    }
    asm volatile("s_waitcnt lgkmcnt(0)" ::: "memory"); __builtin_amdgcn_s_barrier(); asm volatile("" ::: "memory");
    f32x4 w[2][2];
#pragma unroll
    for (int bj = 0; bj < 2; ++bj)
#pragma unroll
      for (int n = 0; n < 2; ++n) w[bj][n] = *(const f32x4*)(fw + col0 + bj * 128 + n * 4);
#pragma unroll
    for (int ai = 0; ai < 2; ++ai)
#pragma unroll
      for (int m = 0; m < 4; ++m) {
        const int r = ai * 128 + wr * 64 + m * 16 + fr;
        const float rs = S[r];
        float* op = out + (size_t)(rowt + r) * D + col0;
#pragma unroll
        for (int bj = 0; bj < 2; ++bj) {
          *(f32x4*)(op + bj * 128) = acc[ai][bj][m][0] * rs * w[bj][0];
          *(f32x4*)(op + bj * 128 + 4) = acc[ai][bj][m][1] * rs * w[bj][1];
        }
      }
  }
};

#define FOR_ITEMS(g, N) for (long g = (long)bid * NT + tid; g < (long)(N); g += (long)nb * NT)

constexpr int OUT1_UNITS = (ML / 256) * (D / 256);
constexpr int NPHASES = 17;
template <int PH>
__device__ __forceinline__ void run_phase(const Params& p, int bid, int nb, LAS unsigned char* lds, const int wave_s, const XcdBarrier xb) {
  const int tid = fresh_tid(wave_s);
  const int wave = wave_s, lane = tid & 63;
  const int gw = bid * 8 + wave, ngw = nb * 8;
  LAS float* scr = (LAS float*)(lds + wave * 8704);
  if constexpr (PH == 0) {
    adaln_phase(p, bid, nb, lds, tid);
    __syncthreads();
    FOR_ITEMS(g, (long)SEQ * 32) { float cs, sn; rope_angle((int)(g / 32), (int)(g % 32), cs, sn); p.ROPE[g * 2] = cs; p.ROPE[g * 2 + 1] = sn; }
    transpose_matrix<0>(p.e_w_in, D, EVEN_IN, EVEN_IN, p.Bt0, gw, ngw, scr, lane);
  }
  if constexpr (PH == 1) normmod_phase(p, 0, gw, ngw, lane);
  if constexpr (PH == 2) {
    pg8::StaticOrder S; S.init(M, EVEN_IN, nb, bid);
    pg8::gemm_phase(lds, pg8::Gemm{p.H, p.Bt0, M, EVEN_IN, D}, S, GEpiIn0{p.QKV0, p.U0, p.G0}, tid);
    constexpr int NU2 = (M / 256) * (EVEN_IN / 256);
    const int busy = NU2 % nb;
    if (bid >= busy) {
      const int gw2 = (bid - busy) * 8 + wave, ngw2 = (nb - busy) * 8;
      transpose_matrix<0>(p.e_w_out, 2048, D, D, p.BtOut0, gw2, ngw2, scr, lane);
      rwkv_prep_phase(p, bid - busy, nb - busy, tid);
    }
  }
  if constexpr (PH == 3) rwkv_lr_phase(p, bid, nb, tid);
  if constexpr (PH == 4) {
    { pg8::StaticOrder S; S.init(M, 4096, nb, bid);
      pg8::gemm_phase(lds, pg8::Gemm{p.LRb, p.Btm, M, 4096, 256}, S, GEpiTerms{GEpiTermsP{p.rw_w0, p.rw_a0, p.DL, p.BB}}, tid); }
#ifdef PROBE_TG
    { pg8::StaticOrder S; S.init(M, 4096, nb, bid);
      pg8::gemm_phase(lds, pg8::Gemm{p.LRb, p.Btm, M, 4096, 256}, S, GEpiTerms{GEpiTermsP{p.rw_w0, p.rw_a0, p.DL, p.BB}}, tid); }
#endif
#ifdef PROBE_NA
    __syncthreads(); na_phase(p, bid, nb, nullptr, 0, lds, wave_s);
#endif
  }
  if constexpr (PH == 5) rwkv_fin_phase(p, bid, nb, tid);
#ifdef RWKV_DIRECT
  if constexpr (PH == 6) rwkv_scan_phase(p, bid, nb, lds, wave_s);
#else
  if constexpr (PH == 6) {
    constexpr int NSC = 2 * BATCH * 16;
    if (nb > NSC) {
      unsigned* ctr = (unsigned*)((char*)p.XC1 - 16384) + NA_CTR_WORD;
      if (bid < NSC) { rwkv_chunk_phase(p, bid, NSC, lds, wave_s); na_phase(p, -1, 0, ctr, nb - NSC, lds, wave_s); }
      else na_phase(p, bid - NSC, 0, ctr, nb - NSC, lds, wave_s);
    } else { rwkv_chunk_phase(p, bid, nb, lds, wave_s); na_phase(p, bid, nb, nullptr, 0, lds, wave_s); }
  }
#endif
  if constexpr (PH == 7) rwkv_out_phase(p, bid, nb, tid);
  if constexpr (PH == 8) {
    constexpr int NU8 = (M / 256) * (D / 256);
    const int busy = (NU8 > nb && NU8 < 2 * nb) ? NU8 - nb : 0;
    const bool fuse = FUSED && nb == OUT1_UNITS;
    auto l1_weights = [&]() {
      const int gw2 = (bid - busy) * 8 + wave, ngw2 = (nb - busy) * 8;
      transpose_matrix<1>(p.o_w_in, D, ODD_IN, N1PAD, p.Bt1, gw2, ngw2, scr, lane);
      transpose_matrix<0>(p.o_w_out, 2048, D, D, p.BtOut1, gw2, ngw2, scr, lane);
      transpose_matrix<0>(p.mla_w_uq, 512, 1536, 1536, p.Buq, gw2, ngw2, scr, lane);
      transpose_matrix<0>(p.mla_w_ukv, 512, 2048, 2048, p.Bukv, gw2, ngw2, scr, lane);
    };
    if (fuse) {
      if (bid >= busy) { l1_weights(); __syncthreads(); }
      Out0Order S; S.init(nb, bid);
      pg8::gemm_phase(lds, pg8::Gemm{p.YALL, p.BtOut0, M, D, 2048}, S, GEpiOut0Fused{p.x, p.ctx, p.mod, p.norm_w, p.XC1, p.X1b, p.H, (float*)p.QKV0, xb}, tid);
      normmod_phase(p, 1, gw, ngw, lane, ML);
    } else {
      pg8::StaticOrder S; S.init(M, D, nb, bid);
      pg8::gemm_phase(lds, pg8::Gemm{p.YALL, p.BtOut0, M, D, 2048}, S, GEpiOut<0>{p.x, p.ctx, p.mod, p.XC1, p.X1b, p.X2b}, tid);
      if (bid >= busy) l1_weights();
    }
  }
  if constexpr (PH == 9) { if (!(FUSED && nb == OUT1_UNITS)) normmod_phase(p, 1, gw, ngw, lane); }
  if constexpr (PH == 10) {
    In1OrderAll S; S.init(nb, bid);
    pg8::gemm_phase(lds, pg8::Gemm{p.H, p.Bt1, M, N1PAD, D, p.Bt1 + (size_t)1024 * D, p.H}, S,
                    GEpiIn1All{GEpiIn1{p.CQKV, p.HGQ, p.HGF, p.HGI, p.G1, p.hg_lb}, GEpiHgT{p.HGQ, p.HGF, p.HGI, p.hg_lb}}, tid);
  }
  if constexpr (PH == 11) {
    mla_prep_phase(p, gw, ngw, lane);
  }
  if constexpr (PH == 12) {
    constexpr int NHG = 2 * BATCH * 8 * 2;
    if (nb > NHG) {
      if (bid < NHG) hg_scan_phase(p, bid, NHG, lds, wave_s);
      else { UpOrder S; S.init(nb - NHG, bid - NHG);
        pg8::gemm_phase(lds, pg8::Gemm{p.CQN, p.Buq, ML + M, 1536 + 2048, 512}, S, GEpiUp{GEpiQ{p.Q, p.ROPE}, GEpiKV{p.KV}}, tid); }
    } else {
      hg_scan_phase(p, bid, nb, lds, wave_s);
      UpOrder S; S.init(nb, bid);
      pg8::gemm_phase(lds, pg8::Gemm{p.CQN, p.Buq, ML + M, 1536 + 2048, 512}, S, GEpiUp{GEpiQ{p.Q, p.ROPE}, GEpiKV{p.KV}}, tid);
    }
  }
  if constexpr (PH == 14) {
    hg_out_phase(p, bid, nb, tid);
    mla_phase(p, bid, nb, lds, wave_s);
  }
  if constexpr (PH == 15) {
    pg8::StaticOrder S; S.init(ML, D, nb, bid);
    if (FUSED && nb == OUT1_UNITS)
      pg8::gemm_phase(lds, pg8::Gemm{p.YALL, p.BtOut1, ML, D, 2048}, S, GEpiOutFinal{p.mod, p.final_norm_w, p.X1b, p.out, (float*)p.HGI, xb}, tid);
    else
      pg8::gemm_phase(lds, pg8::Gemm{p.YALL, p.BtOut1, ML, D, 2048}, S, GEpiOut<1>{p.x, p.ctx, p.mod, p.XC1, p.X1b, p.X2b}, tid);
  }
  if constexpr (PH == 16) { if (!(FUSED && nb == OUT1_UNITS)) final_phase(p, gw, ngw, lane); }
}

#if FUSED
template <int PH>
__device__ __forceinline__ void run_from(const Params& p, cg::grid_group& grid, LAS unsigned char* lds, const int wave_s, const XcdBarrier& xb) {
  if constexpr (PH != 13) {
    if constexpr ((PROBE_DUP >> PH) & 1) { run_phase<PH>(p, blockIdx.x, gridDim.x, lds, wave_s, xb); xcd_barrier(xb, fresh_tid(wave_s) == 0); }
    if constexpr (PH == 9) { if (gridDim.x == OUT1_UNITS) { run_from<PH + 1>(p, grid, lds, wave_s, xb); return; } }
    run_phase<PH>(p, blockIdx.x, gridDim.x, lds, wave_s, xb);
    if constexpr (PH + 1 < NPHASES) { if (!(PH == 15 && gridDim.x == OUT1_UNITS)) xcd_barrier(xb, fresh_tid(wave_s) == 0); }
  }
  if constexpr (PH + 1 < NPHASES) run_from<PH + 1>(p, grid, lds, wave_s, xb);
}
__global__ void __launch_bounds__(NT) mega_kernel(const Params p) {
  extern __shared__ __attribute__((aligned(16))) unsigned char lds_raw[];
  LAS unsigned char* lds = (LAS unsigned char*)lds_raw;
  cg::grid_group grid = cg::this_grid();
  const int wave_s = __builtin_amdgcn_readfirstlane(threadIdx.x >> 6);
  volatile LAS unsigned* xst = (volatile LAS unsigned*)(lds + LDS_BYTES - 16);
  { const int t = fresh_tid(wave_s); if (t < 4) xst[t] = 0u; }
  __syncthreads();
  const XcdBarrier xb = xcd_barrier_post((unsigned*)((char*)p.XC1 - 16384), xst, fresh_tid(wave_s) == 0);
  grid.sync();
  run_from<0>(p, grid, lds, wave_s, xb);
}
#else
template <int PH>
__global__ void __launch_bounds__(NT) phase_kernel(const Params p) {
  extern __shared__ __attribute__((aligned(16))) unsigned char lds_raw[];
  LAS unsigned char* lds = (LAS unsigned char*)lds_raw;
  run_phase<PH>(p, blockIdx.x, gridDim.x, lds, __builtin_amdgcn_readfirstlane(threadIdx.x >> 6), XcdBarrier{});
}
template <int PH>
static void launch_from(const Params& p, hipStream_t stream) {
  (void)hipFuncSetAttribute((const void*)phase_kernel<PH>, hipFuncAttributeMaxDynamicSharedMemorySize, LDS_BYTES);
  phase_kernel<PH><<<dim3(256), dim3(NT), LDS_BYTES, stream>>>(p);
  if constexpr (PH + 1 < NPHASES) launch_from<PH + 1>(p, stream);
}
#endif

extern "C" void kernel_launch(void* const* d_in, const int* in_sizes, int n_in, void* d_out, int out_size, void* d_ws, size_t ws_size,
                              hipStream_t stream) {
  Params p;
  memset(&p, 0, sizeof(p));
  const float** f = (const float**)&p;
  for (int i = 0; i < 29; i++) f[i] = (const float*)d_in[i];
  p.out = (float*)d_out;
  const size_t need = setup_ws(p, (unsigned char*)d_ws, (unsigned char*)d_out);
  if (need > ws_size) { fprintf(stderr, "kernel_launch: workspace too small: need %zu have %zu\n", need, ws_size); return; }
#if FUSED
  static int grid_blocks = 0;
  if (!grid_blocks) {
    int dev = 0, cus = 0, per_cu = 0;
    (void)hipGetDevice(&dev);
    (void)hipDeviceGetAttribute(&cus, hipDeviceAttributeMultiprocessorCount, dev);
    (void)hipFuncSetAttribute((const void*)mega_kernel, hipFuncAttributeMaxDynamicSharedMemorySize, LDS_BYTES);
    (void)hipOccupancyMaxActiveBlocksPerMultiprocessor(&per_cu, mega_kernel, NT, LDS_BYTES);
    if (per_cu > 1) per_cu = 1;
    grid_blocks = cus * per_cu;
  }
  (void)hipMemsetAsync((char*)p.XC1 - 16384, 0, 16384, stream);
  void* args[] = {(void*)&p};
  hipError_t e = hipLaunchCooperativeKernel((void*)mega_kernel, dim3(grid_blocks), dim3(NT), args, LDS_BYTES, stream);
  if (e != hipSuccess) fprintf(stderr, "cooperative launch failed: %s (grid %d)\n", hipGetErrorString(e), grid_blocks);
#else
  launch_from<0>(p, stream);
#endif
}
#endif
```

```cpp
#ifndef HOST_TEST
#include <hip/hip_runtime.h>
#include <hip/hip_cooperative_groups.h>
#include <cstdio>
#include <cstring>
namespace cg = cooperative_groups;
#define HD __host__ __device__ __forceinline__
#else
#include <cmath>
#include <cstdio>
#include <cstdlib>
#include <cstring>
#define HD inline
#endif

#ifndef FUSED
#define FUSED 1
#endif
#ifndef PROBE_DUP
#define PROBE_DUP 0
#endif

typedef unsigned short bf16;
typedef _Float16 f16;

#ifdef HOST_TEST
constexpr int D = HT_D, BATCH = HT_B, SEQ = HT_SEQ, CTX = HT_CTX;
#else
constexpr int D = 2048, BATCH = 4, SEQ = 2048, CTX = 256;
#endif
constexpr int ML = BATCH * SEQ;
constexpr int MC = BATCH * CTX;
constexpr int M = ML + MC;
constexpr int GW = 64, ROWS = SEQ / GW;
constexpr int D3 = 3 * D;
constexpr int EVEN_IN = 8448, ODD_IN = 7232;
constexpr int NMOD = BATCH + 1;
constexpr float NORM_EPS = 1e-6f;

struct Params {
  const float *x, *c, *ctx, *c_ctx, *ada_w, *ada_b, *norm_w, *e_w_in, *e_w_out, *na_rpb, *rw_mu, *rw_w0, *rw_w2, *rw_a0, *rw_a2,
      *rw_k_k, *rw_k_a, *rw_r_k, *rw_ln_w, *rw_ln_b, *o_w_in, *o_w_out, *mla_q_norm, *mla_w_uq, *mla_kv_norm, *mla_w_ukv, *hg_lb,
      *hg_norm_w, *final_norm_w;
  float* out;
  float* mod;
  bf16* H;
  bf16* YALL;
  float* XC1;
  bf16* QKV0;
  bf16* G0;
  bf16* U0;
  f16* Yd;
  bf16* LRb;
  float* LR;
  float* KN;
  f16 *R, *V, *KK;
  f16 *KD, *BB, *DL;
  bf16* CQKV;
  bf16 *HGQ, *HGI;
  bf16* HGF;
  bf16* G1;
  bf16 *CQN;
  bf16 *CKVN;
  bf16* KPE;
  bf16* Q;
  bf16* KV;
  f16* O1d;
  bf16 *Bt0, *BtOut0, *Bt1, *BtOut1, *Buq, *Bukv, *Btm;
  bf16 *X1b, *X2b;
  float* ROPE;
};

HD float bf2f(bf16 v) {
  union { unsigned u; float f; } x;
  x.u = ((unsigned)v) << 16;
  return x.f;
}
HD bf16 f2bf(float f) {
#if defined(__HIP_DEVICE_COMPILE__)
  return __builtin_bit_cast(unsigned short, (__bf16)f);
#else
  union { unsigned u; float f; } x;
  x.f = f;
  unsigned r = x.u + 0x7FFFu + ((x.u >> 16) & 1u);
  return (bf16)(r >> 16);
#endif
}
HD float sigmoidf_(float x) { return 1.0f / (1.0f + expf(-x)); }
HD float siluf_(float x) { return x / (1.0f + expf(-x)); }
HD int clampi(int v, int lo, int hi) { return v < lo ? lo : (v > hi ? hi : v); }
HD long kvrow(long m) {
  return m < ML ? (m / SEQ) * (SEQ + CTX) + m % SEQ : ((m - ML) / CTX) * (SEQ + CTX) + SEQ + (m - ML) % CTX;
}

#if defined(__HIP_DEVICE_COMPILE__)
#define UNIFORM(x) __builtin_amdgcn_readfirstlane(x)
#else
#define UNIFORM(x) (x)
#endif

HD void atomic_addf(float* p, float v) {
#if defined(__HIP_DEVICE_COMPILE__)
  atomicAdd(p, v);
#elif defined(HOST_TEST)
#pragma omp atomic
  *p += v;
#else
  *p += v;
#endif
}

constexpr long N_ADALN = 2L * D3;
HD void body_adaln(const Params& p, long gid) {
  int l = (int)(gid / D3), j = (int)(gid % D3);
  float acc[NMOD];
#pragma unroll
  for (int r = 0; r < NMOD; r++) acc[r] = 0.f;
  const float* w = p.ada_w + (long)l * D * D3 + j;
  for (int k = 0; k < D; k++) {
    float wv = w[(long)k * D3];
#pragma unroll
    for (int r = 0; r < NMOD; r++) {
      float cv = (r < BATCH) ? p.c[r * D + k] : p.c_ctx[k];
      acc[r] += siluf_(cv) * wv;
    }
  }
#pragma unroll
  for (int r = 0; r < NMOD; r++) p.mod[((long)l * NMOD + r) * D3 + j] = acc[r] + p.ada_b[l * D3 + j];
}

HD void body_normmod(const Params& p, int l, long m) {
  const float* src;
  int r;
  if (m < ML) {
    src = (l == 0 ? p.x : p.out) + m * D;
    r = (int)(m / SEQ);
  } else {
    src = (l == 0 ? p.ctx : p.XC1) + (m - ML) * D;
    r = BATCH;
  }
  float ss = 0.f;
  for (int k = 0; k < D; k++) ss += src[k] * src[k];
  float rstd = 1.0f / sqrtf(ss / D + NORM_EPS);
  const float* md = p.mod + ((long)l * NMOD + r) * D3;
  const float* nw = p.norm_w + l * D;
  for (int k = 0; k < D; k++) p.H[m * D + k] = f2bf(src[k] * rstd * nw[k] * (1.0f + md[D + k]) + md[k]);
}

struct EpiIn0 {
  const Params p_;
  HD void operator()(int m, int n, float v) const {
    if (n < 3072) p_.QKV0[(long)m * 3072 + n] = f2bf(v);
    else if (n < 6400) p_.U0[(long)m * 3328 + (n - 3072)] = f2bf(v);
    else p_.G0[(long)m * 2048 + (n - 6400)] = f2bf(siluf_(v));
  }
};
struct EpiOut0 {
  const Params p_;
  HD void operator()(int m, int n, float v) const {
    if (m < ML) {
      int b = m / SEQ;
      p_.out[(long)m * D + n] = p_.x[(long)m * D + n] + p_.mod[((long)0 * NMOD + b) * D3 + 2 * D + n] * v;
    } else {
      p_.XC1[(long)(m - ML) * D + n] = p_.ctx[(long)(m - ML) * D + n] + p_.mod[((long)0 * NMOD + BATCH) * D3 + 2 * D + n] * v;
    }
  }
};
struct EpiIn1 {
  const Params p_;
  HD void operator()(int m, int n, float v) const {
    if (n < 1088) p_.CQKV[(long)m * 1088 + n] = f2bf(v);
    else if (n < 2112) p_.HGQ[(long)m * 1024 + (n - 1088)] = f2bf(v);
    else if (n < 3136) p_.HGF[(long)m * 1024 + (n - 2112)] = f2bf(v);
    else if (n < 4160) p_.HGF[((long)M + m) * 1024 + (n - 3136)] = f2bf(v);
    else if (n < 5184) p_.HGI[(long)m * 1024 + (n - 4160)] = f2bf(v);
    else if (m < ML) p_.G1[(long)m * 2048 + (n - 5184)] = f2bf(siluf_(v));
  }
};
struct EpiQ {
  const Params p_;
  HD void operator()(int m, int n, float v) const { p_.Q[(long)m * 1536 + n] = f2bf(v); }
};
struct EpiKV {
  const Params p_;
  HD void operator()(int m, int n, float v) const { p_.KV[kvrow(m) * 2048 + n] = f2bf(v); }
};
struct EpiOut1 {
  const Params p_;
  HD void operator()(int m, int n, float v) const {
    int b = m / SEQ;
    p_.out[(long)m * D + n] += p_.mod[((long)1 * NMOD + b) * D3 + 2 * D + n] * v;
  }
};

HD float ushift(const Params& p, long m, int c) {
  bool first, last;
  if (m < ML) {
    int t = (int)(m % SEQ);
    first = (t == 0);
    last = (t == SEQ - 1);
  } else {
    int t = (int)((m - ML) % CTX);
    first = (t == 0);
    last = (t == CTX - 1);
  }
  float u = bf2f(p.U0[m * 3328 + c]);
  float pv = first ? 0.f : bf2f(p.U0[(m - 1) * 3328 + c]);
  float nx = last ? 0.f : bf2f(p.U0[(m + 1) * 3328 + c]);
  return u + p.rw_mu[c] * (pv - u) + p.rw_mu[3328 + c] * (nx - u);
}

constexpr long N_LR = (long)M * 256;
HD void body_rwkv_lr(const Params& p, long gid) {
  long m = gid / 256;
  int j = (int)(gid % 256);
  float v = ushift(p, m, 3072 + j);
  p.LR[gid] = (j < 128) ? tanhf(v) : v;
}
constexpr long N_KN = (long)M * 16;
HD void body_rwkv_kn(const Params& p, long gid) {
  long m = gid / 16;
  int h = (int)(gid % 16);
  float ss = 0.f;
  for (int i = 0; i < 64; i++) {
    int c = h * 64 + i;
    float k = ushift(p, m, 1024 + c) * p.rw_k_k[c];
    ss += k * k;
  }
  p.KN[gid] = 1.0f / fmaxf(sqrtf(ss), 1e-12f);
}
constexpr long N_TERMS = (long)M * 1024;
HD void body_rwkv_terms(const Params& p, long gid) {
  long m = gid / 1024;
  int c = (int)(gid % 1024);
  float r = ushift(p, m, c), k = ushift(p, m, 1024 + c), v = ushift(p, m, 2048 + c);
  float kk = k * p.rw_k_k[c] * p.KN[m * 16 + (c >> 6)];
  p.R[gid] = (f16)r;
  p.V[gid] = (f16)v;
  p.KK[gid] = (f16)(-kk);
  const float* lr = p.LR + m * 256;
#pragma unroll
  for (int d = 0; d < 2; d++) {
    float w = p.rw_w0[d * 1024 + c], a = p.rw_a0[d * 1024 + c];
    const float* w2 = p.rw_w2 + (long)d * 64 * 1024 + c;
    const float* a2 = p.rw_a2 + (long)d * 64 * 1024 + c;
    for (int j = 0; j < 64; j++) {
      w += lr[d * 64 + j] * w2[j * 1024];
      a += lr[128 + d * 64 + j] * a2[j * 1024];
    }
    float e = sigmoidf_(w) * 0.60653065971263342f;
    a = sigmoidf_(a);
    float kd = k * (1.0f + (a - 1.0f) * p.rw_k_a[c]);
    long o = (long)d * M * 1024 + gid;
    p.DL[o] = (f16)(expm1f(-e));
    p.KD[o] = (f16)kd;
    p.BB[o] = (f16)(kk * a);
  }
}

constexpr long N_NA = 4L * 8 * M;
HD void body_na(const Params& p, long gid) {
  long m = gid % M;
  int h = (int)((gid / M) % 8);
  int dc = (int)(gid / ((long)M * 8));
  const bf16* q = p.QKV0 + m * 3072 + h * 128;
  const float scale = 0.08838834764831845f;
  float o[32];
#pragma unroll
  for (int i = 0; i < 32; i++) o[i] = 0.f;
  float mx = -1e30f, l = 0.f;
  int b;
  int nloc = 0, r = 0, j = 0, r0 = 0, c0 = 0;
  if (m < ML) {
    b = (int)(m / SEQ);
    int t = (int)(m % SEQ);
    r = t / GW;
    j = t % GW;
    r0 = clampi(r - 4, 0, ROWS - 8);
    c0 = clampi(j - 8, 0, GW - 16);
    nloc = 128;
  } else {
    b = (int)((m - ML) / CTX);
  }
  for (int kidx = 0; kidx < nloc + CTX; kidx++) {
    long mk;
    float bias = 0.f;
    if (kidx < nloc) {
      int a = kidx >> 4, kx = kidx & 15;
      mk = (long)b * SEQ + (r0 + a) * GW + c0 + kx;
      bias = p.na_rpb[(h * 15 + (r0 + a - r + 7)) * 31 + (c0 + kx - j + 15)];
    } else {
      mk = ML + (long)b * CTX + (kidx - nloc);
    }
    const bf16* kp = p.QKV0 + mk * 3072 + 1024 + h * 128;
    float s = 0.f;
    for (int d = 0; d < 128; d++) s += bf2f(q[d]) * bf2f(kp[d]);
    s = s * scale + bias;
    if (s > mx) {
      float f = expf(mx - s);
      l *= f;
#pragma unroll
      for (int i = 0; i < 32; i++) o[i] *= f;
      mx = s;
    }
    float pe = expf(s - mx);
    l += pe;
    const bf16* vp = p.QKV0 + mk * 3072 + 2048 + h * 128 + dc * 32;
#pragma unroll
    for (int i = 0; i < 32; i++) o[i] += pe * bf2f(vp[i]);
  }
  float inv = 1.0f / l;
  int col = h * 128 + dc * 32;
#pragma unroll
  for (int i = 0; i < 32; i++) p.YALL[m * 2048 + col + i] = f2bf(o[i] * inv * bf2f(p.G0[m * 2048 + col + i]));
}

constexpr long N_RWSCAN = 2L * BATCH * 16 * 64;
HD void body_rwkv_scan(const Params& p, long gid) {
  int v = (int)(gid % 64);
  int h = UNIFORM((int)((gid / 64) % 16));
  int b = UNIFORM((int)((gid / 1024) % BATCH));
  int d = UNIFORM((int)(gid / (1024L * BATCH)));
  float S[64];
#pragma unroll
  for (int i = 0; i < 64; i++) S[i] = 0.f;
  for (int ph = 0; ph < 2; ph++) {
    int Tn = ph == 0 ? CTX : SEQ;
    long base = ph == 0 ? (ML + (long)b * CTX) : ((long)b * SEQ);
    for (int s = 0; s < Tn; s++) {
      int t = d == 0 ? s : Tn - 1 - s;
      long m = base + t;
      long o1 = m * 1024 + h * 64;
      long o2 = (long)d * M * 1024 + o1;
      float vv = (float)p.V[o1 + v];
      float sa = 0.f;
#pragma unroll
      for (int i = 0; i < 64; i++) sa += S[i] * (float)p.KK[o1 + i];
      float y = 0.f;
#pragma unroll
      for (int i = 0; i < 64; i++) {
        float sn = S[i] + S[i] * (float)p.DL[o2 + i] + sa * (float)p.BB[o2 + i] + vv * (float)p.KD[o2 + i];
        S[i] = sn;
        y += sn * (float)p.R[o1 + i];
      }
      p.Yd[o2 + v] = (f16)y;
    }
  }
}

constexpr long N_RWOUT = (long)M * 16;
HD void body_rwkv_out(const Params& p, long gid) {
  long m = gid / 16;
  int h = (int)(gid % 16);
  long o1 = m * 1024 + h * 64;
  const long o2 = (long)M * 1024 + o1;
  float mu = 0.f;
  for (int i = 0; i < 64; i++) mu += (float)p.Yd[o1 + i] + (float)p.Yd[o2 + i];
  mu *= (1.0f / 64);
  float var = 0.f, bonus = 0.f;
  for (int i = 0; i < 64; i++) {
    float dlt = (float)p.Yd[o1 + i] + (float)p.Yd[o2 + i] - mu;
    var += dlt * dlt;
    float kd = (float)p.KD[o1 + i] + (float)p.KD[o2 + i];
    bonus += (float)p.R[o1 + i] * kd * p.rw_r_k[h * 64 + i];
  }
  float rs = 1.0f / sqrtf(var * (1.0f / 64) + 64e-5f);
  for (int i = 0; i < 64; i++) {
    int c = h * 64 + i;
    float yn = ((float)p.Yd[o1 + i] + (float)p.Yd[o2 + i] - mu) * rs * p.rw_ln_w[c] + p.rw_ln_b[c] + bonus * (float)p.V[o1 + i];
    p.YALL[m * 2048 + 1024 + c] = f2bf(yn * bf2f(p.G0[m * 2048 + 1024 + c]));
  }
}

HD void rope_angle(int t, int i, float& cs, float& sn) {
  int f = i & 15;
  float pos = (float)((i < 16) ? (t / GW) : (t % GW));
  float inv = powf(10000.0f, -(float)f / 16.0f);
  float ang = pos * inv;
  cs = cosf(ang);
  sn = sinf(ang);
}
HD void body_mla_prep(const Params& p, long m) {
  const bf16* z = p.CQKV + m * 1088;
  if (m < ML) {
    float ss = 0.f;
    for (int k = 0; k < 512; k++) ss += bf2f(z[k]) * bf2f(z[k]);
    float rstd = 1.0f / sqrtf(ss / 512 + NORM_EPS);
    for (int k = 0; k < 512; k++) p.CQN[m * 512 + k] = f2bf(bf2f(z[k]) * rstd * p.mla_q_norm[k]);
  }
  {
    float ss = 0.f;
    for (int k = 0; k < 512; k++) ss += bf2f(z[512 + k]) * bf2f(z[512 + k]);
    float rstd = 1.0f / sqrtf(ss / 512 + NORM_EPS);
    for (int k = 0; k < 512; k++) p.CKVN[m * 512 + k] = f2bf(bf2f(z[512 + k]) * rstd * p.mla_kv_norm[k]);
  }
  for (int i = 0; i < 32; i++) {
    float x0 = bf2f(z[1024 + 2 * i]), x1 = bf2f(z[1024 + 2 * i + 1]);
    if (m < ML) {
      float cs, sn;
      rope_angle((int)(m % SEQ), i, cs, sn);
      float y0 = x0 * cs - x1 * sn, y1 = x0 * sn + x1 * cs;
      x0 = y0;
      x1 = y1;
    }
    p.KPE[kvrow(m) * 64 + 2 * i] = f2bf(x0);
    p.KPE[kvrow(m) * 64 + 2 * i + 1] = f2bf(x1);
  }
}
constexpr long N_ROPEQ = (long)ML * 8 * 32;
HD void body_rope_q(const Params& p, long gid) {
  int i = (int)(gid % 32);
  int h = (int)((gid / 32) % 8);
  long m = gid / 256;
  bf16* q = p.Q + m * 1536 + h * 192 + 128 + 2 * i;
  float cs, sn;
  rope_angle((int)(m % SEQ), i, cs, sn);
  float x0 = bf2f(q[0]), x1 = bf2f(q[1]);
  q[0] = f2bf(x0 * cs - x1 * sn);
  q[1] = f2bf(x0 * sn + x1 * cs);
}

constexpr long N_MLA = 4L * BATCH * 8 * SEQ;
HD void body_mla(const Params& p, long gid) {
  int t = (int)(gid % SEQ);
  int h = UNIFORM((int)((gid / SEQ) % 8));
  int b = UNIFORM((int)((gid / (8L * SEQ)) % BATCH));
  int dc = UNIFORM((int)(gid / (8L * SEQ * BATCH)));
  long m = (long)b * SEQ + t;
  const bf16* q = p.Q + m * 1536 + h * 192;
  const float scale = 0.07216878364870322f;
  float o[32];
#pragma unroll
  for (int i = 0; i < 32; i++) o[i] = 0.f;
  float mx = -1e30f, l = 0.f;
  for (int kidx = 0; kidx < SEQ + CTX; kidx++) {
    long mk = (long)b * (SEQ + CTX) + kidx;
    const bf16* kn = p.KV + mk * 2048 + h * 256;
    const bf16* kp = p.KPE + mk * 64;
    float s = 0.f;
    for (int d = 0; d < 128; d++) s += bf2f(q[d]) * bf2f(kn[d]);
    for (int d = 0; d < 64; d++) s += bf2f(q[128 + d]) * bf2f(kp[d]);
    s *= scale;
    if (s > mx) {
      float f = expf(mx - s);
      l *= f;
#pragma unroll
      for (int i = 0; i < 32; i++) o[i] *= f;
      mx = s;
    }
    float pe = expf(s - mx);
    l += pe;
    const bf16* vp = kn + 128 + dc * 32;
#pragma unroll
    for (int i = 0; i < 32; i++) o[i] += pe * bf2f(vp[i]);
  }
  float inv = 1.0f / l;
  int col = h * 128 + dc * 32;
#pragma unroll
  for (int i = 0; i < 32; i++) p.YALL[m * 2048 + col + i] = f2bf(o[i] * inv * bf2f(p.G1[m * 2048 + col + i]));
}

constexpr long N_HGSCAN = 2L * BATCH * 8 * 128;
HD void body_hg_scan(const Params& p, long gid) {
  int e = (int)(gid % 128);
  int h = UNIFORM((int)((gid / 128) % 8));
  int b = UNIFORM((int)((gid / 1024) % BATCH));
  int d = UNIFORM((int)(gid / (1024L * BATCH)));
  float S[128];
#pragma unroll
  for (int i = 0; i < 128; i++) S[i] = 0.f;
  for (int ph = 0; ph < 2; ph++) {
    int Tn = ph == 0 ? CTX : SEQ;
    long base = ph == 0 ? (ML + (long)b * CTX) : ((long)b * SEQ);
    for (int s = 0; s < Tn; s++) {
      int t = d == 0 ? s : Tn - 1 - s;
      long m = base + t;
      long o1 = m * 1024 + h * 128;
      const bf16* fp = p.HGF + (long)d * M * 1024 + o1;
      float vv = bf2f(p.HGI[o1 + e]);
      float o = 0.f;
#pragma unroll
      for (int i = 0; i < 128; i++) {
        float h0 = p.hg_lb[h * 128 + i], h1 = p.hg_lb[1024 + h * 128 + i];
        float lb = 1.0f / (1.0f + expf(h0 - h1));
        float sg = sigmoidf_(bf2f(fp[i]));
        float f = lb + (1.0f - lb) * sg;
        float kk = (1.0f - lb) * (1.0f - sg);
        float sn = f * S[i] + kk * vv;
        S[i] = sn;
        o += bf2f(p.HGQ[o1 + i]) * sn;
      }
      if (ph == 1) p.O1d[(long)d * ML * 1024 + o1 + e] = (f16)o;
    }
  }
}
constexpr long N_HGOUT = (long)ML * 8;
HD void body_hg_out(const Params& p, long gid) {
  long m = gid / 8;
  int h = (int)(gid % 8);
  long o1 = m * 1024 + h * 128;
  const long o2 = (long)ML * 1024 + o1;
  float ss = 0.f;
  for (int i = 0; i < 128; i++) { float o = (float)p.O1d[o1 + i] + (float)p.O1d[o2 + i]; ss += o * o; }
  float rstd = 1.0f / sqrtf(ss / 128 + NORM_EPS);
  for (int i = 0; i < 128; i++) {
    int c = 1024 + h * 128 + i;
    float o = (float)p.O1d[o1 + i] + (float)p.O1d[o2 + i];
    p.YALL[m * 2048 + c] = f2bf(o * rstd * p.hg_norm_w[i] * bf2f(p.G1[m * 2048 + c]));
  }
}

HD void body_final(const Params& p, long m) {
  float* x = p.out + m * D;
  float ss = 0.f;
  for (int k = 0; k < D; k++) ss += x[k] * x[k];
  float rstd = 1.0f / sqrtf(ss / D + NORM_EPS);
  for (int k = 0; k < D; k++) x[k] = x[k] * rstd * p.final_norm_w[k];
}


constexpr int HG_C = 32, HG_LDQ = 136, HG_LDT = 40;
constexpr int HG_OFF_QI = 0, HG_OFF_KI = HG_OFF_QI + HG_C * HG_LDQ * 2, HG_OFF_KET = HG_OFF_KI + HG_C * HG_LDQ * 2, HG_OFF_VT = HG_OFF_KET + 128 * HG_LDT * 2,
              HG_OFF_DEC = HG_OFF_VT + 128 * HG_LDT * 2, HG_OFF_GS = HG_OFF_DEC + 512, HG_LDS = HG_OFF_GS + 2048;
HD long seq_row(int d, int b, int g) {
  if (g < CTX) return ML + (long)b * CTX + (d ? CTX - 1 - g : g);
  g -= CTX;
  return (long)b * SEQ + (d ? SEQ - 1 - g : g);
}
HD int kperm(int g, int j) { return 16 * (j >> 2) + 4 * g + (j & 3); }


constexpr int RC = 16, RC_LD = 72, RC_LDJ = 40;
constexpr int RC_AT = 0, RC_RT = RC_AT + 16 * RC_LD * 2, RC_BT = RC_RT + 16 * RC_LD * 2, RC_KT = RC_BT + 16 * RC_LD * 2, RC_KH = RC_KT + 16 * RC_LD * 2,
              RC_VT = RC_KH + 64 * RC_LDJ * 2, RC_BH = RC_VT + 64 * RC_LDJ * 2, RC_PC = RC_BH + 64 * 16 * 2, RC_IMG = RC_PC + 256;
constexpr int RC_NKT = 0, RC_MKT = RC_NKT + 16 * RC_LDJ * 2, RC_TT = RC_MKT + 16 * RC_LDJ * 2, RC_MBT = RC_TT + 16 * 16 * 2, RC_MAT = RC_MBT + 16 * 16 * 2;
constexpr int RC_MAT0 = 3 * RC_IMG, RC_NBF = RC_MAT0 + 2 * RC_MAT, RC_GP = RC_NBF + 16 * 20 * 4, RC_LDS = RC_GP + 8 * 64 * 4;

HD size_t al256(size_t x) { return (x + 255) & ~(size_t)255; }
constexpr int N1PAD = 7424;
inline size_t setup_ws(Params& p, unsigned char* ws, unsigned char* outbuf) {
  size_t o = 0;
  auto take = [&](size_t bytes) {
    unsigned char* r = ws + o;
    o += al256(bytes);
    return r;
  };
  p.mod = (float*)take(sizeof(float) * 2 * NMOD * D3);
  p.ROPE = (float*)take(4L * SEQ * 64);
  p.H = (bf16*)take(2L * M * (D > 2048 ? D : 2048));
  p.YALL = p.H;
  take(16384);
  p.XC1 = (float*)take(4L * MC * D);
  p.BtOut0 = (bf16*)take(2L * D * 2048);
  p.Btm = (bf16*)take(2L * 4096 * 256);
  size_t mark = o;
  p.QKV0 = (bf16*)take(2L * M * 3072);
  p.G0 = (bf16*)take(2L * M * 2048);
  p.LR = (float*)take(4L * M * 256);
  p.LRb = (bf16*)p.LR;
  p.KN = (float*)take(4L * M * 16);
  size_t terms0 = o;
  p.R = (f16*)take(2L * M * 1024);
  p.V = (f16*)take(2L * M * 1024);
  p.KK = (f16*)take(2L * M * 1024);
  p.KD = (f16*)take(2L * 2 * M * 1024);
  p.BB = (f16*)take(2L * 2 * M * 1024);
  p.DL = (f16*)take(2L * 2 * M * 1024);
  size_t end0 = o;
  p.Bt0 = (bf16*)(ws + terms0);
  p.U0 = (bf16*)outbuf;
  p.Yd = (f16*)outbuf;
  o = mark;
  p.CQKV = (bf16*)take(2L * M * 1088);
  p.HGQ = (bf16*)take(2L * M * 1024);
  p.X2b = p.CQKV;
  p.X1b = (bf16*)outbuf;
  p.HGI = (bf16*)take(2L * M * 1024);
  p.HGF = (bf16*)take(2L * 2 * M * 1024);
  p.G1 = (bf16*)take(2L * ML * 2048);
  p.CQN = (bf16*)take(2L * ML * 512);
  p.CKVN = (bf16*)take(2L * M * 512);
  p.KPE = (bf16*)take(2L * M * 64);
  p.Q = (bf16*)take(2L * ML * 1536);
  p.KV = (bf16*)take(2L * M * 2048);
  p.O1d = (f16*)take(2L * 2 * ML * 1024);
  p.Bt1 = (bf16*)take(2L * N1PAD * D);
  p.BtOut1 = (bf16*)take(2L * D * 2048);
  p.Buq = (bf16*)take(2L * 1536 * 512);
  p.Bukv = (bf16*)take(2L * 2048 * 512);
  size_t end1 = o;
  return end0 > end1 ? end0 : end1;
}

#ifndef HOST_TEST
#define LAS __attribute__((address_space(3)))
__device__ __forceinline__ int fresh_tid(int wave_s) {
  int lane;
  asm volatile("v_mbcnt_lo_u32_b32 %0, -1, 0\n\tv_mbcnt_hi_u32_b32 %0, -1, %0" : "=v"(lane));
  return wave_s * 64 + lane;
}
#define WG_BAR_LDS() do { asm volatile("s_waitcnt lgkmcnt(0)" ::: "memory"); __builtin_amdgcn_s_barrier(); asm volatile("" ::: "memory"); } while (0)
constexpr int NT = 512;
constexpr int LDS_BYTES = 152 * 1024;

namespace pg8 {
#define PG8_LAS __attribute__((address_space(3)))
typedef unsigned short bf16_t;
typedef short bf16x8 __attribute__((ext_vector_type(8)));
typedef float f32x4 __attribute__((ext_vector_type(4)));
typedef unsigned u32x4 __attribute__((ext_vector_type(4)));
constexpr int BM = 256, BK = 64, HALF = 128, HTB = HALF * BK * 2  , STAGE_BYTES = 8 * HTB, NXCD = 8, WGM = 8;

__host__ __device__ __forceinline__ int lds_byte(int r, int c) { const int st = (r >> 4) * 2 + (c >> 5), rr = r & 15, cc = c & 31, ob = rr * 64 + cc * 2; return st * 1024 + (ob ^ (((ob >> 9) & 1) << 5)); }
__host__ __device__ __forceinline__ void stage_rc(int b, int& R, int& C) { const int st = b / 1024, sb = b % 1024, swz = sb ^ (((sb >> 9) & 1) << 5); R = (st >> 1) * 16 + swz / 64; C = (st & 1) * 32 + (swz % 64) / 2; }
__host__ __device__ __forceinline__ int perm32(int rho) { const int n = rho >> 4, i = rho & 15; return 8 * (i >> 2) + 4 * n + (i & 3); }

struct Unit { int pm, pn, kind = 0; };
struct Gemm { const bf16_t* A; const bf16_t* Bt; int M, N, K; const bf16_t* A2 = nullptr; const bf16_t* Bt2 = nullptr; };

struct StaticOrder {
    int nM, nN, nwg, G, c;
    __host__ __device__ void init(int M, int N, int G_, int c_) { nM = M / BM; nN = N / BM; nwg = nM * nN; G = G_; c = c_; }
    __host__ __device__ bool next(int i, Unit& u) const {
        const long L = (long)i * G + c; if (L >= nwg) return false;
        map((int)L, u); return true;
    }
    __host__ __device__ void map(int L, Unit& u) const {
        int wgid = L; { const int q = nwg / NXCD, r = nwg % NXCD, xcd = wgid % NXCD, off = wgid / NXCD; wgid = (xcd < r ? xcd * (q + 1) : r * (q + 1) + (xcd - r) * q) + off; }
        const int nig = WGM * nN, gid = wgid / nig, fm = gid * WGM, gsz = (nM - fm) < WGM ? (nM - fm) : WGM;
        u.pm = fm + ((wgid % nig) % gsz); u.pn = (wgid % nig) / gsz;
    }
    __device__ __forceinline__ void a_ready(const Unit&) const {}
    __device__ __forceinline__ void done(const Unit&) const {}
};
__device__ __forceinline__ unsigned cvt_pk_bf16(float lo, float hi) { unsigned r; asm volatile("v_cvt_pk_bf16_f32 %0, %1, %2" : "=v"(r) : "v"(lo), "v"(hi)); return r; }
template <class Epi, class Sched, bool STAMP = false>
__device__ __forceinline__ void gemm_phase(PG8_LAS unsigned char* lds, const Gemm g, const Sched& S, const Epi& E, const int tid) {
    const int wid = __builtin_amdgcn_readfirstlane(tid >> 6), lane = tid & 63, wr = wid >> 2, wc = wid & 3, fr = lane & 15, fq = lane >> 4;
    const int K = g.K, nt = K / BK;
    unsigned voffA[2], voffB[2];
#pragma unroll
    for (int i = 0; i < 2; ++i) { int R, C; stage_rc(tid * 16 + i * 8192, R, C); const int Rb = Epi::PERM ? ((R & ~31) + perm32(R & 31)) : R;
        voffA[i] = (unsigned)(R * K + C) * 2u; voffB[i] = (unsigned)(Rb * K + C) * 2u; }
    const size_t kstep = (size_t)(BK * 2);
    const size_t hstep = (size_t)HALF * K * 2;
    const size_t tstep = 2 * hstep;
    const unsigned ldsw = (unsigned)wid * 1024u;
    const int aoff = lds_byte(wr * 64 + fr, fq * 8), boff = lds_byte(wc * 32 + fr, fq * 8);
#define PG8_SA(b, h) (((b) * 2 + (h)) * HTB)
#define PG8_SB(b, h) ((4 + (b) * 2 + (h)) * HTB)
#define PG8_STAGE(bufoff, gbase, voff) do { _Pragma("unroll") for (int _i = 0; _i < 2; ++_i) \
        __builtin_amdgcn_global_load_lds((const unsigned*)((const char*)(gbase) + (voff)[_i]), (PG8_LAS unsigned*)(lds + (bufoff) + ldsw + _i * 8192), 16, 0, 0); } while (0)
#define PG8_LDA(dst, b, h) do { _Pragma("unroll") for (int m = 0; m < 4; ++m) _Pragma("unroll") for (int k = 0; k < 2; ++k) dst[m][k] = *(const PG8_LAS bf16x8*)(lds + PG8_SA(b, h) + aoff + m * 2048 + k * 1024); } while (0)
#define PG8_LDB(dst, b, h) do { _Pragma("unroll") for (int n = 0; n < 2; ++n) _Pragma("unroll") for (int k = 0; k < 2; ++k) dst[n][k] = *(const PG8_LAS bf16x8*)(lds + PG8_SB(b, h) + boff + n * 2048 + k * 1024); } while (0)
#define PG8_MMA(ai, bj, At, Bt) do { __builtin_amdgcn_s_setprio(1); _Pragma("unroll") for (int m = 0; m < 4; ++m) _Pragma("unroll") for (int n = 0; n < 2; ++n) _Pragma("unroll") for (int k = 0; k < 2; ++k) \
        acc[ai][bj][m][n] = __builtin_amdgcn_mfma_f32_16x16x32_bf16(Bt[n][k], At[m][k], acc[ai][bj][m][n], 0, 0, 0); __builtin_amdgcn_s_setprio(0); } while (0)
#define PG8_WAIT_V(n) asm volatile("s_waitcnt vmcnt(" #n ")" ::: "memory")
#define PG8_WAIT_L(n) asm volatile("s_waitcnt lgkmcnt(" #n ")" ::: "memory")
#define PG8_BAR __builtin_amdgcn_s_barrier()
#define PG8_SCHED __builtin_amdgcn_sched_barrier(0)
    Unit cur, nxt; int ui = 0;
    if (!S.next(0, cur)) return;
    f32x4 acc[2][2][4][2];
#pragma unroll
    for (int a = 0; a < 2; ++a)
#pragma unroll
        for (int b = 0; b < 2; ++b)
#pragma unroll
            for (int m = 0; m < 4; ++m)
#pragma unroll
                for (int n = 0; n < 2; ++n) acc[a][b][m][n] = (f32x4){0.f, 0.f, 0.f, 0.f};
    bf16x8 At[4][2], B0[2][2], B1[2][2];
    const char* cA = (const char*)(cur.kind ? g.A2 : g.A) + (size_t)cur.pm * tstep; const char* cB = (const char*)(cur.kind ? g.Bt2 : g.Bt) + (size_t)cur.pn * tstep;
    S.a_ready(cur);
    PG8_STAGE(PG8_SB(0, 0), cB, voffB); PG8_STAGE(PG8_SA(0, 0), cA, voffA); PG8_STAGE(PG8_SB(0, 1), cB + hstep, voffB); PG8_STAGE(PG8_SA(0, 1), cA + hstep, voffA);
    if (wr == 1) PG8_BAR;
    PG8_WAIT_V(4); PG8_BAR;
    PG8_STAGE(PG8_SB(1, 0), cB + kstep, voffB); PG8_STAGE(PG8_SA(1, 0), cA + kstep, voffA); PG8_STAGE(PG8_SB(1, 1), cB + hstep + kstep, voffB);
    PG8_WAIT_V(6); PG8_BAR;
    for (;;) {
        const bool has_next = S.next(ui + 1, nxt);
        const char* nA = has_next ? (const char*)(nxt.kind ? g.A2 : g.A) + (size_t)nxt.pm * tstep : cA; const char* nB = has_next ? (const char*)(nxt.kind ? g.Bt2 : g.Bt) + (size_t)nxt.pn * tstep : cB;
        for (int t = 0; t < nt; t += 2) {
            const bool last = (t == nt - 2);
            const char* a1 = cA + (size_t)(t + 1) * kstep;
            const char* a2 = last ? nA : cA + (size_t)(t + 2) * kstep; const char* b2 = last ? nB : cB + (size_t)(t + 2) * kstep;
            const char* a3 = a2 + kstep; const char* b3 = b2 + kstep;
            if (last && has_next) S.a_ready(nxt);
            PG8_LDB(B0, 0, 0); PG8_SCHED; PG8_LDA(At, 0, 0); PG8_STAGE(PG8_SA(1, 1), a1 + hstep, voffA);
            PG8_WAIT_L(8); PG8_BAR; PG8_WAIT_L(0); PG8_MMA(0, 0, At, B0); PG8_BAR; PG8_SCHED;
            PG8_LDB(B1, 0, 1); PG8_STAGE(PG8_SB(0, 0), b2, voffB);
            PG8_BAR; PG8_WAIT_L(0); PG8_MMA(0, 1, At, B1); PG8_BAR;
            PG8_LDA(At, 0, 1); PG8_STAGE(PG8_SA(0, 0), a2, voffA);
            PG8_BAR; PG8_WAIT_L(0); PG8_MMA(1, 0, At, B0); PG8_BAR; PG8_SCHED;
            PG8_STAGE(PG8_SB(0, 1), b2 + hstep, voffB);
            PG8_WAIT_V(6); PG8_BAR; PG8_MMA(1, 1, At, B1); PG8_BAR;
            PG8_LDB(B0, 1, 0); PG8_SCHED; PG8_LDA(At, 1, 0); PG8_STAGE(PG8_SA(0, 1), a2 + hstep, voffA);
            PG8_WAIT_L(8); PG8_BAR; PG8_WAIT_L(0); PG8_MMA(0, 0, At, B0); PG8_BAR; PG8_SCHED;
            PG8_LDB(B1, 1, 1); PG8_STAGE(PG8_SB(1, 0), b3, voffB);
            PG8_BAR; PG8_WAIT_L(0); PG8_MMA(0, 1, At, B1); PG8_BAR;
            PG8_LDA(At, 1, 1); PG8_STAGE(PG8_SA(1, 0), a3, voffA);
            PG8_BAR; PG8_WAIT_L(0); PG8_MMA(1, 0, At, B0); PG8_BAR; PG8_SCHED;
            PG8_STAGE(PG8_SB(1, 1), b3 + hstep, voffB);
            PG8_WAIT_V(6); PG8_BAR; PG8_MMA(1, 1, At, B1); PG8_BAR;
        }
        if constexpr (!Epi::AFTER_DRAIN) { E(acc, cur, wr, wc, fr, fq); S.done(cur); }
        else if (has_next) { E(acc, cur, wr, wc, fr, fq); S.done(cur); }
        if (!has_next) break;
#pragma unroll
        for (int a = 0; a < 2; ++a)
#pragma unroll
            for (int b = 0; b < 2; ++b)
#pragma unroll
                for (int m = 0; m < 4; ++m)
#pragma unroll
                    for (int n = 0; n < 2; ++n) acc[a][b][m][n] = (f32x4){0.f, 0.f, 0.f, 0.f};
        cur = nxt; cA = nA; cB = nB; ++ui;
    }
    PG8_WAIT_V(0);
    if (wr == 0) PG8_BAR;
    PG8_BAR;
    if constexpr (Epi::AFTER_DRAIN) { E.fused(acc, cur, wr, wc, fr, fq, lds, wid, lane); S.done(cur); }
#undef PG8_SA
#undef PG8_SB
#undef PG8_STAGE
#undef PG8_LDA
#undef PG8_LDB
#undef PG8_MMA
#undef PG8_WAIT_V
#undef PG8_WAIT_L
#undef PG8_BAR
#undef PG8_SCHED
}
}

using pg8::f32x4;
using pg8::u32x4;
__device__ __forceinline__ float silu_fast(float x) { return x * __builtin_amdgcn_rcpf(1.0f + __expf(-x)); }
template <bool ACT>
__device__ __forceinline__ u32x4 pack8(f32x4 v0, f32x4 v1) {
  if (ACT) {
#pragma unroll
    for (int j = 0; j < 4; j++) { v0[j] = silu_fast(v0[j]); v1[j] = silu_fast(v1[j]); }
  }
  u32x4 w;
  w.x = pg8::cvt_pk_bf16(v0[0], v0[1]); w.y = pg8::cvt_pk_bf16(v0[2], v0[3]);
  w.z = pg8::cvt_pk_bf16(v1[0], v1[1]); w.w = pg8::cvt_pk_bf16(v1[2], v1[3]);
  return w;
}
struct GEpiIn0 {
  static constexpr bool PERM = true, AFTER_DRAIN = false;
  bf16 *QKV0, *U0, *G0;
  __device__ __forceinline__ void operator()(const f32x4 (&acc)[2][2][4][2], const pg8::Unit& u, int wr, int wc, int fr, int fq) const {
    const int colt = u.pn * 256;
    bf16* base; int ld, cb; bool act = false;
    if (colt < 3072) { base = QKV0; ld = 3072; cb = colt; }
    else if (colt < 6400) { base = U0; ld = 3328; cb = colt - 3072; }
    else { base = G0; ld = 2048; cb = colt - 6400; act = true; }
    const int row0 = u.pm * 256 + wr * 64 + fr, col0 = cb + wc * 32 + 8 * fq;
#pragma unroll
    for (int ai = 0; ai < 2; ++ai)
#pragma unroll
      for (int m = 0; m < 4; ++m) {
        bf16* rowp = base + (size_t)(row0 + ai * 128 + m * 16) * ld + col0;
#pragma unroll
        for (int bj = 0; bj < 2; ++bj)
          *(u32x4*)(rowp + bj * 128) = act ? pack8<true>(acc[ai][bj][m][0], acc[ai][bj][m][1]) : pack8<false>(acc[ai][bj][m][0], acc[ai][bj][m][1]);
      }
  }
};
struct GEpiIn1 {
  static constexpr bool PERM = true, AFTER_DRAIN = false;
  bf16 *CQKV, *HGQ, *HGF, *HGI, *G1;
  const float* hg_lb;
  __device__ __forceinline__ void operator()(const f32x4 (&acc)[2][2][4][2], const pg8::Unit& u, int wr, int wc, int fr, int fq) const {
    const int colt = u.pn * 256;
    if (colt >= 2048 && colt < 4096) {
      bf16* base = HGF + (size_t)(colt >= 3072) * M * 1024; const int cb = colt & 1023;
      const int row0 = u.pm * 256 + wr * 64 + fr;
#pragma unroll
      for (int bj = 0; bj < 2; ++bj) {
        const int c = cb + bj * 128 + wc * 32 + 8 * fq;
        f32x4 oml[2];
#pragma unroll
        for (int n = 0; n < 2; ++n) {
          const f32x4 h0 = *(const f32x4*)(hg_lb + c + 4 * n), h1 = *(const f32x4*)(hg_lb + 1024 + c + 4 * n);
#pragma unroll
          for (int j = 0; j < 4; ++j) oml[n][j] = __builtin_amdgcn_rcpf(1.0f + __expf(h1[j] - h0[j]));
        }
#pragma unroll
        for (int ai = 0; ai < 2; ++ai)
#pragma unroll
          for (int m = 0; m < 4; ++m) {
            f32x4 o[2];
#pragma unroll
            for (int n = 0; n < 2; ++n)
#pragma unroll
              for (int j = 0; j < 4; ++j) o[n][j] = oml[n][j] * __builtin_amdgcn_rcpf(1.0f + __expf(acc[ai][bj][m][n][j]));
            *(u32x4*)(base + (size_t)(row0 + ai * 128 + m * 16) * 1024 + c) = pack8<false>(o[0], o[1]);
          }
      }
      return;
    }
    bf16* base; int ld, cb; bool act = false; int climit = 256;
    if (colt < 1024) { base = CQKV; ld = 1088; cb = colt; }
    else if (colt < 2048) { base = HGQ; ld = 1024; cb = colt - 1024; }
    else if (colt < 3072) { base = HGF; ld = 1024; cb = colt - 2048; }
    else if (colt < 4096) { base = HGF + (size_t)M * 1024; ld = 1024; cb = colt - 3072; }
    else if (colt < 5120) { base = HGI; ld = 1024; cb = colt - 4096; }
    else if (colt < 7168) { base = G1; ld = 2048; cb = colt - 5120; act = true; if (u.pm * 256 >= ML) return; }
    else { base = CQKV; ld = 1088; cb = 1024; climit = 64; }
    const int row0 = u.pm * 256 + wr * 64 + fr, cl = wc * 32 + 8 * fq;
#pragma unroll
    for (int ai = 0; ai < 2; ++ai)
#pragma unroll
      for (int m = 0; m < 4; ++m) {
        bf16* rowp = base + (size_t)(row0 + ai * 128 + m * 16) * ld + cb + cl;
#pragma unroll
        for (int bj = 0; bj < 2; ++bj)
          if (cl + bj * 128 < climit)
            *(u32x4*)(rowp + bj * 128) = act ? pack8<true>(acc[ai][bj][m][0], acc[ai][bj][m][1]) : pack8<false>(acc[ai][bj][m][0], acc[ai][bj][m][1]);
      }
  }
};
template <int LAYER>
struct GEpiOut {
  static constexpr bool PERM = true, AFTER_DRAIN = false;
  const float *x, *ctx, *mod;
  float* XC1; bf16 *X1b, *X2b;
  __device__ __forceinline__ void operator()(const f32x4 (&acc)[2][2][4][2], const pg8::Unit& u, int wr, int wc, int fr, int fq) const {
    const int rowt = u.pm * 256;
    const bool lat = rowt < ML;
    const float* gate = mod + ((size_t)LAYER * NMOD + (lat ? rowt / SEQ : BATCH)) * D3 + 2 * D;
    const int rbase = lat ? rowt : rowt - ML;
    const float* src; if (lat) src = x; else src = ctx;
    const int col0 = u.pn * 256 + wc * 32 + 8 * fq;
    f32x4 g[2][2];
#pragma unroll
    for (int bj = 0; bj < 2; ++bj)
#pragma unroll
      for (int n = 0; n < 2; ++n) g[bj][n] = *(const f32x4*)(gate + col0 + bj * 128 + n * 4);
#pragma unroll
    for (int ai = 0; ai < 2; ++ai)
#pragma unroll
      for (int m = 0; m < 4; ++m) {
        const size_t off = (size_t)(rbase + wr * 64 + fr + ai * 128 + m * 16) * D + col0;
#pragma unroll
        for (int bj = 0; bj < 2; ++bj) {
          f32x4 s0, s1;
          if (LAYER == 0 || !lat) {
            s0 = *(const f32x4*)(src + off + bj * 128); s1 = *(const f32x4*)(src + off + bj * 128 + 4);
          } else {
            const u32x4 w = *(const u32x4*)(X1b + off + bj * 128);
            s0 = (f32x4){__uint_as_float(w.x << 16), __uint_as_float(w.x & 0xffff0000u), __uint_as_float(w.y << 16), __uint_as_float(w.y & 0xffff0000u)};
            s1 = (f32x4){__uint_as_float(w.z << 16), __uint_as_float(w.z & 0xffff0000u), __uint_as_float(w.w << 16), __uint_as_float(w.w & 0xffff0000u)};
          }
          const f32x4 o0 = s0 + g[bj][0] * acc[ai][bj][m][0], o1 = s1 + g[bj][1] * acc[ai][bj][m][1];
          if (lat) *(u32x4*)((LAYER == 0 ? X1b : X2b) + off + bj * 128) = pack8<false>(o0, o1);
          else { *(f32x4*)(XC1 + off + bj * 128) = o0; *(f32x4*)(XC1 + off + bj * 128 + 4) = o1; }
        }
        if (m & 1) asm volatile("" ::: "memory");
      }
  }
};
struct GEpiQ {
  static constexpr bool PERM = true, AFTER_DRAIN = false;
  bf16* Q; const float* ROPE;
  __device__ __forceinline__ void operator()(const f32x4 (&acc)[2][2][4][2], const pg8::Unit& u, int wr, int wc, int fr, int fq) const {
    const int row0 = u.pm * 256 + wr * 64 + fr;
#pragma unroll
    for (int bj = 0; bj < 2; ++bj) {
      const int c0 = u.pn * 256 + bj * 128 + wc * 32 + 8 * fq;
      const int off = c0 % 192;
      const bool rope = off >= 128;
      const int pi = (off - 128) >> 1;
#pragma unroll
      for (int ai = 0; ai < 2; ++ai)
#pragma unroll
        for (int m = 0; m < 4; ++m) {
          const int row = row0 + ai * 128 + m * 16;
          f32x4 v0 = acc[ai][bj][m][0], v1 = acc[ai][bj][m][1];
          if (rope) {
            const f32x4* rt = (const f32x4*)(ROPE + ((size_t)(row % SEQ) * 32 + pi) * 2);
            const f32x4 cs0 = rt[0], cs1 = rt[1];
            f32x4 w0, w1;
            w0[0] = v0[0] * cs0[0] - v0[1] * cs0[1]; w0[1] = v0[0] * cs0[1] + v0[1] * cs0[0];
            w0[2] = v0[2] * cs0[2] - v0[3] * cs0[3]; w0[3] = v0[2] * cs0[3] + v0[3] * cs0[2];
            w1[0] = v1[0] * cs1[0] - v1[1] * cs1[1]; w1[1] = v1[0] * cs1[1] + v1[1] * cs1[0];
            w1[2] = v1[2] * cs1[2] - v1[3] * cs1[3]; w1[3] = v1[2] * cs1[3] + v1[3] * cs1[2];
            v0 = w0; v1 = w1;
          }
          *(u32x4*)(Q + (size_t)row * 1536 + c0) = pack8<false>(v0, v1);
        }
    }
  }
};
struct GEpiKV {
  static constexpr bool PERM = true, AFTER_DRAIN = false;
  bf16* KV;
  __device__ __forceinline__ void operator()(const f32x4 (&acc)[2][2][4][2], const pg8::Unit& u, int wr, int wc, int fr, int fq) const {
    const int row0 = u.pm * 256 + wr * 64 + fr, col0 = u.pn * 256 + wc * 32 + 8 * fq;
#pragma unroll
    for (int ai = 0; ai < 2; ++ai)
#pragma unroll
      for (int m = 0; m < 4; ++m) {
        bf16* rowp = KV + (size_t)kvrow(row0 + ai * 128 + m * 16) * 2048 + col0;
#pragma unroll
        for (int bj = 0; bj < 2; ++bj) *(u32x4*)(rowp + bj * 128) = pack8<false>(acc[ai][bj][m][0], acc[ai][bj][m][1]);
      }
  }
};

struct UpOrder {
  pg8::StaticOrder sq, sk; int G, c;
  __device__ void init(int G_, int c_) { sq.init(ML, 1536, G_, c_); sk.init(M, 2048, G_, c_); G = G_; c = c_; }
  __device__ bool next(int i, pg8::Unit& u) const {
    const long L = (long)i * G + c;
    constexpr int NQ = (ML / 256) * 6, NK = (M / 256) * 8;
    if (L >= NQ + NK) return false;
    if (L < NQ) { sq.map((int)L, u); return true; }
    sk.map((int)(L - NQ), u); u.pm += ML / 256; u.pn += 6;
    return true;
  }
  __device__ __forceinline__ void a_ready(const pg8::Unit&) const {}
  __device__ __forceinline__ void done(const pg8::Unit&) const {}
};
struct GEpiUp {
  static constexpr bool PERM = true, AFTER_DRAIN = false;
  GEpiQ q; GEpiKV kv;
  __device__ __forceinline__ void operator()(const f32x4 (&acc)[2][2][4][2], const pg8::Unit& u, int wr, int wc, int fr, int fq) const {
    if (u.pn < 6) q(acc, u, wr, wc, fr, fq);
    else { pg8::Unit v; v.pm = u.pm - ML / 256; v.pn = u.pn - 6; kv(acc, v, wr, wc, fr, fq); }
  }
};
struct In1Order {
  pg8::StaticOrder so; int G, c;
  __device__ void init(int G_, int c_) { so.init(ML, N1PAD, G_, c_); G = G_; c = c_; }
  __device__ bool next(int i, pg8::Unit& u) const {
    const long L = (long)i * G + c;
    constexpr int NLAT = (ML / 256) * (N1PAD / 256), NCTX = (MC / 256) * 19;
    if (L >= NLAT + NCTX) return false;
    if (L < NLAT) { so.map((int)L, u); return true; }
    const int r = (int)(L - NLAT);
    u.pm = ML / 256 + r % (MC / 256);
    const int idx = r / (MC / 256);
    u.pn = idx < 18 ? 2 + idx : 28;
    return true;
  }
  __device__ __forceinline__ void a_ready(const pg8::Unit&) const {}
  __device__ __forceinline__ void done(const pg8::Unit&) const {}
};

struct In1OrderN {
  pg8::StaticOrder so; int G, c;
  __device__ void init(int G_, int c_) { so.init(ML, 13 * 256, G_, c_); G = G_; c = c_; }
  __device__ bool next(int i, pg8::Unit& u) const {
    const long L = (long)i * G + c;
    constexpr int NLAT = (ML / 256) * 13, NCTX = (MC / 256) * 3;
    if (L >= NLAT + NCTX) return false;
    if (L < NLAT) { so.map((int)L, u); u.pn = u.pn < 4 ? u.pn : u.pn + 16; return true; }
    const int r = (int)(L - NLAT);
    u.pm = ML / 256 + r % (MC / 256);
    const int idx = r / (MC / 256);
    u.pn = idx < 2 ? 2 + idx : 28;
    return true;
  }
  __device__ __forceinline__ void a_ready(const pg8::Unit&) const {}
  __device__ __forceinline__ void done(const pg8::Unit&) const {}
};
struct In1OrderAll {
  pg8::StaticOrder st; In1OrderN sn; int G, c;
  __device__ void init(int G_, int c_) { st.init(4096, M, G_, c_); sn.init(G_, c_); G = G_; c = c_; }
  __device__ bool next(int i, pg8::Unit& u) const {
    const long L = (long)i * G + c;
    constexpr int NT_ = 16 * (M / 256);
    if (L < NT_) { st.map((int)L, u); u.kind = 1; return true; }
    const long Ln = L - NT_;
    constexpr int NLAT = (ML / 256) * 13, NCTX = (MC / 256) * 3;
    if (Ln >= NLAT + NCTX) return false;
    u.kind = 0;
    if (Ln < NLAT) { sn.so.map((int)Ln, u); u.pn = u.pn < 4 ? u.pn : u.pn + 16; return true; }
    const int r = (int)(Ln - NLAT);
    u.pm = ML / 256 + r % (MC / 256);
    const int idx = r / (MC / 256);
    u.pn = idx < 2 ? 2 + idx : 28;
    return true;
  }
  __device__ __forceinline__ void a_ready(const pg8::Unit&) const {}
  __device__ __forceinline__ void done(const pg8::Unit&) const {}
};
struct GEpiHgT {
  static constexpr bool PERM = true, AFTER_DRAIN = false;
  bf16 *HGQ, *HGF, *HGI; const float* hg_lb;
  __device__ __forceinline__ void operator()(const f32x4 (&acc)[2][2][4][2], const pg8::Unit& u, int wr, int wc, int fr, int fq) const {
    const int plane = u.pm >> 2;
    bf16* base; if (plane == 0) base = HGQ; else if (plane == 3) base = HGI; else base = HGF + (size_t)(plane - 1) * M * 1024;
    const bool isf = plane == 1 || plane == 2;
    const int m0 = u.pn * 256 + wc * 32 + 8 * fq;
#pragma unroll
    for (int ai = 0; ai < 2; ++ai)
#pragma unroll
      for (int m = 0; m < 4; ++m) {
        const int col = ((u.pm & 3) * 256) + ai * 128 + wr * 64 + m * 16 + fr;
        float oml = 1.f;
        if (isf) oml = __builtin_amdgcn_rcpf(1.0f + __expf(hg_lb[1024 + col] - hg_lb[col]));
        bf16* rowp = base + ((size_t)(m0 >> 5) * 1024 + col) * 32 + (m0 & 31);
#pragma unroll
        for (int bj = 0; bj < 2; ++bj) {
          f32x4 o0 = acc[ai][bj][m][0], o1 = acc[ai][bj][m][1];
          if (isf) {
#pragma unroll
            for (int j = 0; j < 4; ++j) { o0[j] = oml * __builtin_amdgcn_rcpf(1.0f + __expf(o0[j])); o1[j] = oml * __builtin_amdgcn_rcpf(1.0f + __expf(o1[j])); }
          }
          *(u32x4*)(rowp + (size_t)bj * 4 * 1024 * 32) = pack8<false>(o0, o1);
        }
      }
  }
};

struct GEpiIn1All {
  static constexpr bool PERM = true, AFTER_DRAIN = false;
  GEpiIn1 n; GEpiHgT t;
  __device__ __forceinline__ void operator()(const f32x4 (&acc)[2][2][4][2], const pg8::Unit& u, int wr, int wc, int fr, int fq) const {
    if (u.kind) t(acc, u, wr, wc, fr, fq); else n(acc, u, wr, wc, fr, fq);
  }
};
__device__ __forceinline__ unsigned pk2(float lo, float hi) { return pg8::cvt_pk_bf16(lo, hi); }
__device__ __forceinline__ void transpose_item(const float* __restrict__ W, int K, int N, bf16* __restrict__ WT, int k0, int nsrc, int ndst, LAS float* scr, int lane) {
  if (nsrc >= 0) {
    f32x4 t[8];
#pragma unroll
    for (int i = 0; i < 8; ++i) t[i] = *(const f32x4*)(W + (size_t)(k0 + (lane >> 3) + 8 * i) * N + nsrc + (lane & 7) * 4);
#pragma unroll
    for (int i = 0; i < 8; ++i) { LAS float* d = scr + ((lane >> 3) + 8 * i) * 33 + (lane & 7) * 4; d[0] = t[i][0]; d[1] = t[i][1]; d[2] = t[i][2]; d[3] = t[i][3]; }
  }
  asm volatile("s_waitcnt vmcnt(0) lgkmcnt(0)" ::: "memory");
  const int c = lane & 7;
#pragma unroll
  for (int j = 0; j < 4; ++j) {
    const int n = (lane >> 3) + 8 * j; const LAS float* sp = scr + (8 * c) * 33 + n;
    u32x4 o;
    if (nsrc >= 0) { o.x = pk2(sp[0 * 33], sp[1 * 33]); o.y = pk2(sp[2 * 33], sp[3 * 33]); o.z = pk2(sp[4 * 33], sp[5 * 33]); o.w = pk2(sp[6 * 33], sp[7 * 33]); }
    else { o.x = 0; o.y = 0; o.z = 0; o.w = 0; }
    *(u32x4*)(WT + (size_t)(ndst + n) * K + k0 + 8 * c) = o;
  }
  asm volatile("s_waitcnt lgkmcnt(0)" ::: "memory");
}
__device__ __forceinline__ int in1_src(int nd) {
  if (nd < 1024) return nd;
  if (nd < 7168) return nd + 64;
  if (nd < 7232) return nd - 7168 + 1024;
  return -1;
}
template <int KIND>
__device__ __forceinline__ void transpose_matrix(const float* W, int K, int N, int Ndst, bf16* WT, int gw, int ngw, LAS float* scr, int lane) {
  const int nblk = Ndst / 32, items = (K / 64) * nblk;
  for (int it = gw; it < items; it += ngw) {
    const int kb = it / nblk, nb = it % nblk;
    const int nd = nb * 32, ns = KIND == 1 ? in1_src(nd) : nd;
    transpose_item(W, K, N, WT, kb * 64, ns, nd, scr, lane);
  }
}


namespace att {
using bf16x8 = __attribute__((ext_vector_type(8))) short;
using s16x4 = __attribute__((ext_vector_type(4))) short;
using f32x16 = __attribute__((ext_vector_type(16))) float;
using u32x4 = __attribute__((ext_vector_type(4))) unsigned;
constexpr int SHM_V = 64 * 128 * 2, SHM_K = 64 * 128 * 2, SHM_P = 64 * 64 * 2;
constexpr int OFF_V = 0, OFF_K = 2 * SHM_V, OFF_P = OFF_K + 2 * SHM_K, OFF_WS = OFF_P + 2 * SHM_P, OFF_TAB = OFF_WS + 8 * 64 * 4, OFF_QP = OFF_TAB + 2048, LDS_ATT = OFF_QP + 8 * 8192;
#define KSWZ(row, colB) ((row) * 256 + ((colB) ^ (((row) & 7) << 4)))
#define PSWZ(row, colB) ((row) * 128 + ((colB) ^ (((row) & 7) << 4)))
#define SBAR() __builtin_amdgcn_sched_barrier(0)
__device__ __forceinline__ int crow(int r, int hi) { return (r & 3) + 8 * (r >> 2) + 4 * hi; }
__device__ __forceinline__ unsigned cvtpk(float lo, float hi) {
  unsigned r; asm volatile("v_cvt_pk_bf16_f32 %0, %1, %2" : "=v"(r) : "v"(lo), "v"(hi)); return r;
}
__device__ __forceinline__ bf16x8 ld8(const bf16* p) { return *reinterpret_cast<const bf16x8*>(p); }
constexpr float THR = 8.f;
__device__ __forceinline__ void partialSM(f32x16& p0, f32x16& p1, float& m_reg, float& mn, float& alpha, const float SCALE) {
  const float C = SCALE * 1.4426950408889634f;
  float pmax = p0[0];
#pragma unroll
  for (int r = 1; r < 16; ++r) pmax = fmaxf(pmax, p0[r]);
#pragma unroll
  for (int r = 0; r < 16; ++r) pmax = fmaxf(pmax, p1[r]);
  { auto rr = __builtin_amdgcn_permlane32_swap(__float_as_uint(pmax), __float_as_uint(pmax), false, false);
    pmax = fmaxf(__uint_as_float(rr[0]), __uint_as_float(rr[1])); }
  if (__builtin_expect(__all(pmax - m_reg <= THR / SCALE), 1)) { mn = m_reg; alpha = 1.f; }
  else { mn = fmaxf(m_reg, pmax); alpha = __builtin_amdgcn_exp2f((m_reg - mn) * C); m_reg = mn; }
  float mnC = -mn * C;
#pragma unroll
  for (int r = 0; r < 16; ++r) p0[r] = fmaf(p0[r], C, mnC);
#pragma unroll
  for (int r = 0; r < 16; ++r) p1[r] = fmaf(p1[r], C, mnC);
#pragma unroll
  for (int r = 0; r < 16; ++r) p0[r] = __builtin_amdgcn_exp2f(p0[r]);
}
__device__ __forceinline__ void finishSM(f32x16& p0, f32x16& p1, float alpha, float& l_reg, bf16x8& pa0, bf16x8& pa1, bf16x8& pa2, bf16x8& pa3) {
#pragma unroll
  for (int r = 0; r < 16; ++r) p1[r] = __builtin_amdgcn_exp2f(p1[r]);
  float ps = 0;
#pragma unroll
  for (int r = 0; r < 16; ++r) ps += p0[r];
#pragma unroll
  for (int r = 0; r < 16; ++r) ps += p1[r];
  { auto rr = __builtin_amdgcn_permlane32_swap(__float_as_uint(ps), __float_as_uint(ps), false, false);
    ps = __uint_as_float(rr[0]) + __uint_as_float(rr[1]); }
  l_reg = l_reg * alpha + ps;
#define PK4(P, BASE, OUT) do { unsigned a0 = cvtpk(P[BASE + 0], P[BASE + 1]), a1 = cvtpk(P[BASE + 2], P[BASE + 3]);   \
    unsigned b0 = cvtpk(P[BASE + 4], P[BASE + 5]), b1 = cvtpk(P[BASE + 6], P[BASE + 7]);                              \
    auto r0 = __builtin_amdgcn_permlane32_swap(a0, b0, false, false); auto r1 = __builtin_amdgcn_permlane32_swap(a1, b1, false, false); \
    u32x4 w = {r0[0], r1[0], r0[1], r1[1]}; OUT = *reinterpret_cast<bf16x8*>(&w); } while (0)
  PK4(p0, 0, pa0); PK4(p0, 8, pa1); PK4(p1, 0, pa2); PK4(p1, 8, pa3);
#undef PK4
}
template <bool HAS_PE, int NQR>
__device__ __forceinline__ void qkt(f32x16& p0, f32x16& p1, const LAS char* Ks, const LAS char* Ps, const bf16x8* qr, const LAS char* qp, int r32, int hi) {
  p0 = f32x16{}; p1 = f32x16{};
#pragma unroll
  for (int d0 = 0; d0 < 8; ++d0) { int cb = (d0 * 16 + hi * 8) * 2;
    bf16x8 b0 = *reinterpret_cast<const LAS bf16x8*>(Ks + KSWZ(r32, cb));
    bf16x8 b1 = *reinterpret_cast<const LAS bf16x8*>(Ks + KSWZ(32 + r32, cb));
    bf16x8 qf;
    if (d0 >= NQR) qf = *reinterpret_cast<const LAS bf16x8*>(qp + ((HAS_PE ? 4 : 0) + d0 - NQR) * 8192); else qf = qr[d0];
    p0 = __builtin_amdgcn_mfma_f32_32x32x16_bf16(b0, qf, p0, 0, 0, 0);
    p1 = __builtin_amdgcn_mfma_f32_32x32x16_bf16(b1, qf, p1, 0, 0, 0); }
  if constexpr (HAS_PE) {
#pragma unroll
    for (int d0 = 0; d0 < 4; ++d0) { int cb = (d0 * 16 + hi * 8) * 2;
      bf16x8 b0 = *reinterpret_cast<const LAS bf16x8*>(Ps + PSWZ(r32, cb));
      bf16x8 b1 = *reinterpret_cast<const LAS bf16x8*>(Ps + PSWZ(32 + r32, cb));
      const bf16x8 qf = *reinterpret_cast<const LAS bf16x8*>(qp + d0 * 8192);
      p0 = __builtin_amdgcn_mfma_f32_32x32x16_bf16(b0, qf, p0, 0, 0, 0);
      p1 = __builtin_amdgcn_mfma_f32_32x32x16_bf16(b1, qf, p1, 0, 0, 0); }
  }
}
__device__ __forceinline__ int v_st(int k, int c) { const int kk = (k & ~0xC) | ((k & 4) << 1) | ((k & 8) >> 1); return ((kk >> 3) * 4 + (c >> 5)) * 512 + ((kk & 7) * 32 + (c & 31)) * 2; }
__device__ __forceinline__ int v_rd_base(int lane) { return ((lane & 3) << 3) | (((lane >> 2) & 3) << 6) | (((lane >> 4) & 1) << 5) | (((lane >> 5) & 1) << 8); }
constexpr int v_rd_off(int d0, int ks, int half) { return d0 * 512 + ks * 4096 + half * 2048; }
template <int OFF> __device__ __forceinline__ s16x4 tr_read(int vb) {
  s16x4 r; asm volatile("ds_read_b64_tr_b16 %0, %1 offset:%2" : "=&v"(r) : "v"(vb), "i"(OFF) : "memory"); return r;
}
template <int D0> __device__ __forceinline__ void pv_one(f32x16& od, int vb, bf16x8 pa0, bf16x8 pa1, bf16x8 pa2, bf16x8 pa3) {
  const s16x4 l0 = tr_read<v_rd_off(D0, 0, 0)>(vb), h0 = tr_read<v_rd_off(D0, 0, 1)>(vb), l1 = tr_read<v_rd_off(D0, 1, 0)>(vb), h1 = tr_read<v_rd_off(D0, 1, 1)>(vb);
  const s16x4 l2 = tr_read<v_rd_off(D0, 2, 0)>(vb), h2 = tr_read<v_rd_off(D0, 2, 1)>(vb), l3 = tr_read<v_rd_off(D0, 3, 0)>(vb), h3 = tr_read<v_rd_off(D0, 3, 1)>(vb);
  asm volatile("s_waitcnt lgkmcnt(0)" ::: "memory"); SBAR();
#define PK(L, H) (bf16x8){L[0], L[1], L[2], L[3], H[0], H[1], H[2], H[3]}
  od = __builtin_amdgcn_mfma_f32_32x32x16_bf16(pa0, PK(l0, h0), od, 0, 0, 0);
  od = __builtin_amdgcn_mfma_f32_32x32x16_bf16(pa1, PK(l1, h1), od, 0, 0, 0);
  od = __builtin_amdgcn_mfma_f32_32x32x16_bf16(pa2, PK(l2, h2), od, 0, 0, 0);
  od = __builtin_amdgcn_mfma_f32_32x32x16_bf16(pa3, PK(l3, h3), od, 0, 0, 0);
#undef PK
}
__device__ __forceinline__ void pv_d0(f32x16* o, int vb, bf16x8 pa0, bf16x8 pa1, bf16x8 pa2, bf16x8 pa3) {
  pv_one<0>(o[0], vb, pa0, pa1, pa2, pa3); pv_one<1>(o[1], vb, pa0, pa1, pa2, pa3); pv_one<2>(o[2], vb, pa0, pa1, pa2, pa3); pv_one<3>(o[3], vb, pa0, pa1, pa2, pa3);
}
struct TileSrc { const bf16* K; const bf16* V; const bf16* P; };
template <bool HAS_PE, bool HAS_BIAS, int NQR, int ldq, int ldk, int ldo, class Src, class Bias>
__device__ __forceinline__ void attn_body(const bf16* __restrict__ Qb, const Src& src, const Bias& bias, const int NTILES, const float SCALE,
                                          bf16* __restrict__ Ob, const bf16* __restrict__ Gb, LAS char* lds, const int wave_s) {
  const int tid = fresh_tid(wave_s);
  const int wid = tid >> 6, lane = tid & 63, r32 = lane & 31, hi = lane >> 5;
  LAS char* V_lds = lds + OFF_V; LAS char* K_lds = lds + OFF_K; LAS char* P_lds = lds + OFF_P;
  LAS float* ws = (LAS float*)(lds + OFF_WS) + wid * 64; LAS float* li_l = ws; LAS float* al_l = ws + 32;
  float m_reg = -1e30f, l_reg = 0; f32x16 o[4] = {}; bf16x8 qr[NQR > 0 ? NQR : 1];
  const bf16* Qw = Qb + (long)(wid * 32 + r32) * ldq + hi * 8;
#pragma unroll
  for (int d0 = 0; d0 < NQR; ++d0) qr[d0] = ld8(Qw + d0 * 16);
  LAS char* qp = lds + OFF_QP + (wid * 64 + lane) * 16;
  if constexpr (HAS_PE) {
#pragma unroll
    for (int d0 = 0; d0 < 4; ++d0) *(LAS bf16x8*)(qp + d0 * 8192) = ld8(Qw + 128 + d0 * 16);
  }
#pragma unroll
  for (int d0 = NQR; d0 < 8; ++d0) *(LAS bf16x8*)(qp + ((HAS_PE ? 4 : 0) + d0 - NQR) * 8192) = ld8(Qw + d0 * 16);
  const int sr = tid >> 4, sc = (tid & 15) * 8, vst0 = v_st(sr, sc), vst1 = v_st(32 + sr, sc);
  const int pr = tid >> 3, pc = (tid & 7) * 8;
  const int vb0 = (int)(uintptr_t)V_lds + v_rd_base(lane);
  struct { bf16x8 vs0, vs1, ks0, ks1, ps; } sr_[2];
#define SLOAD(i, tile) do { const TileSrc ts_ = src(tile); sr_[i].vs0 = ld8(ts_.V + (long)sr * ldk + sc); sr_[i].vs1 = ld8(ts_.V + (long)(32 + sr) * ldk + sc); \
    sr_[i].ks0 = ld8(ts_.K + (long)sr * ldk + sc); sr_[i].ks1 = ld8(ts_.K + (long)(32 + sr) * ldk + sc); \
    if constexpr (HAS_PE) sr_[i].ps = ld8(ts_.P + pr * 64 + pc); } while (0)
#define SWRITE(b, i) do { *(LAS bf16x8*)(V_lds + (b) * SHM_V + vst0) = sr_[i].vs0;          \
    *(LAS bf16x8*)(V_lds + (b) * SHM_V + vst1) = sr_[i].vs1; int kc = sc * 2;               \
    *(LAS bf16x8*)(K_lds + (b) * SHM_K + KSWZ(sr, kc)) = sr_[i].ks0;                       \
    *(LAS bf16x8*)(K_lds + (b) * SHM_K + KSWZ(32 + sr, kc)) = sr_[i].ks1;                  \
    if constexpr (HAS_PE) *(LAS bf16x8*)(P_lds + (b) * SHM_P + PSWZ(pr, pc * 2)) = sr_[i].ps; } while (0)
#define SWAIT() do { if constexpr (HAS_PE) asm volatile("s_waitcnt vmcnt(5)" ::: "memory"); else asm volatile("s_waitcnt vmcnt(4)" ::: "memory"); } while (0)
#define RESC(a) do { if (__any((a) < 1.f)) { if (hi == 0) al_l[r32] = (a); asm volatile("s_waitcnt lgkmcnt(0)" ::: "memory"); \
    _Pragma("unroll") for (int d = 0; d < 4; ++d) _Pragma("unroll") for (int r = 0; r < 16; ++r) o[d][r] *= al_l[crow(r, hi)]; } } while (0)
  f32x16 pA0, pA1, pB0, pB1; float mnA, mnB, alA, alB; bf16x8 pa0, pa1, pa2, pa3; const int NT_ = NTILES;
  constexpr int SE = 0, SO = 1;
  SLOAD(SE, 0); asm volatile("s_waitcnt vmcnt(0)" ::: "memory"); SWRITE(0, SE); __syncthreads();
  qkt<HAS_PE, NQR>(pA0, pA1, K_lds, P_lds, qr, qp, r32, hi); if constexpr (HAS_BIAS) bias(pA0, pA1, 0, wid, r32, hi); partialSM(pA0, pA1, m_reg, mnA, alA, SCALE);
  SLOAD(SO, 1); if (2 < NT_) SLOAD(SE, 2);
  SWAIT(); SWRITE(1, SO); __syncthreads();
  for (int j = 1; j + 1 < NT_; j += 2) {
    SBAR(); qkt<HAS_PE, NQR>(pB0, pB1, K_lds + SHM_K, P_lds + SHM_P, qr, qp, r32, hi);
    finishSM(pA0, pA1, alA, l_reg, pa0, pa1, pa2, pa3); SBAR();
    SLOAD(SO, j + 2 < NT_ ? j + 2 : j); SBAR();
    pv_d0(o, vb0, pa0, pa1, pa2, pa3); if constexpr (HAS_BIAS) bias(pB0, pB1, j, wid, r32, hi); partialSM(pB0, pB1, m_reg, mnB, alB, SCALE);
    __syncthreads(); SWAIT(); SWRITE(0, SE);
    RESC(alB); __syncthreads();
    SBAR(); qkt<HAS_PE, NQR>(pA0, pA1, K_lds, P_lds, qr, qp, r32, hi);
    finishSM(pB0, pB1, alB, l_reg, pa0, pa1, pa2, pa3); SBAR();
    if (j + 3 < NT_) SLOAD(SE, j + 3); SBAR();
    pv_d0(o, vb0 + SHM_V, pa0, pa1, pa2, pa3); if constexpr (HAS_BIAS) bias(pA0, pA1, j + 1, wid, r32, hi); partialSM(pA0, pA1, m_reg, mnA, alA, SCALE);
    __syncthreads(); SWAIT(); SWRITE(1, SO);
    RESC(alA); __syncthreads();
  }
  SBAR(); qkt<HAS_PE, NQR>(pB0, pB1, K_lds + SHM_K, P_lds + SHM_P, qr, qp, r32, hi);
  finishSM(pA0, pA1, alA, l_reg, pa0, pa1, pa2, pa3); SBAR();
  pv_d0(o, vb0, pa0, pa1, pa2, pa3); if constexpr (HAS_BIAS) bias(pB0, pB1, NT_ - 1, wid, r32, hi); partialSM(pB0, pB1, m_reg, mnB, alB, SCALE);
  __syncthreads(); RESC(alB);
  finishSM(pB0, pB1, alB, l_reg, pa0, pa1, pa2, pa3); SBAR();
  pv_d0(o, vb0 + SHM_V, pa0, pa1, pa2, pa3);
  if (hi == 0) li_l[r32] = l_reg; asm volatile("s_waitcnt lgkmcnt(0)" ::: "memory");
  float rli[16];
#pragma unroll
  for (int r = 0; r < 16; ++r) rli[r] = __builtin_amdgcn_rcpf(li_l[crow(r, hi)]);
  bf16* Ow = Ob + (long)(wid * 32) * ldo; const bf16* Gw = Gb + (long)(wid * 32) * ldo;
#pragma unroll
  for (int r = 0; r < 16; ++r) { const int orow = crow(r, hi);
#pragma unroll
    for (int d0 = 0; d0 < 4; ++d0) { const long idx = (long)orow * ldo + d0 * 32 + r32; Ow[idx] = f2bf(o[d0][r] * rli[r] * bf2f(Gw[idx])); }
    asm volatile("" ::: "memory"); }
#undef SLOAD
#undef SWRITE
#undef SWAIT
#undef RESC
}
static_assert(LDS_ATT <= LDS_BYTES, "attention LDS");
struct NoBias { __device__ __forceinline__ void operator()(f32x16&, f32x16&, int, int, int, int) const {} };
}

struct MlaSrc {
  const bf16 *K, *V, *P;
  __device__ __forceinline__ att::TileSrc operator()(int tile) const { return {K + (long)tile * 64 * 2048, V + (long)tile * 64 * 2048, P + (long)tile * 64 * 64}; }
};
__device__ __forceinline__ void mla_phase(const Params& p, int bid, int nb, LAS unsigned char* lds, const int wave_s) {
  constexpr int NQB = SEQ / 256, NU = BATCH * 8 * NQB;
  for (int unit = bid; unit < NU; unit += nb) {
    const int qb = unit % NQB, h = (unit / NQB) % 8, b = unit / (NQB * 8);
    const long m0 = (long)b * SEQ + qb * 256, kv0 = (long)b * (SEQ + CTX);
    MlaSrc src{p.KV + kv0 * 2048 + h * 256, p.KV + kv0 * 2048 + h * 256 + 128, p.KPE + kv0 * 64};
    __syncthreads();
    att::attn_body<true, false, 6, 1536, 2048, 2048>(p.Q + m0 * 1536 + h * 192, src, att::NoBias{}, (SEQ + CTX) / 64, 0.07216878364870322f,
                                                  p.YALL + m0 * 2048 + h * 128, p.G1 + m0 * 2048 + h * 128, (LAS char*)lds, wave_s);
  }
}


struct NaSrc {
  const bf16* base;
  int b, kr_lo, nloc;
  __device__ __forceinline__ att::TileSrc operator()(int tile) const {
    long row;
    if (tile < nloc) { int kr = kr_lo + tile; kr = kr < ROWS ? kr : ROWS - 1; row = (long)b * SEQ + kr * GW; }
    else row = ML + (long)b * CTX + (tile - nloc) * 64;
    const bf16* r = base + row * 3072;
    return {r + 1024, r + 2048, nullptr};
  }
};
struct NaBias {
  const LAS float* tab;
  int u, kr_lo;
  __device__ __forceinline__ void operator()(att::f32x16& p0, att::f32x16& p1, int tile, int wid, int r32, int hi) const {
    if (tile >= 12) return;
    const int kr = kr_lo + tile, rq = 4 * u + (wid >> 1), r0 = clampi(rq - 4, 0, ROWS - 8);
    const float NEG = -__builtin_inff();
    if (kr < r0 || kr >= r0 + 8) {
#pragma unroll
      for (int r = 0; r < 16; ++r) { p0[r] = NEG; p1[r] = NEG; }
      return;
    }
    const int j = (wid & 1) * 32 + r32, c0 = clampi(j - 8, 0, GW - 16);
    const LAS float* trow = tab + (kr - rq + 7) * 31 + (15 - j);
#pragma unroll
    for (int r = 0; r < 16; ++r) {
      const int c = att::crow(r, hi);
      const bool v0 = (c >= c0) && (c < c0 + 16), v1 = (c + 32 >= c0) && (c + 32 < c0 + 16);
      const float b0 = trow[v0 ? c : j], b1 = trow[v1 ? c + 32 : j];
      p0[r] = v0 ? p0[r] + b0 : NEG;
      p1[r] = v1 ? p1[r] + b1 : NEG;
      if ((r & 3) == 3) asm volatile("" ::: "memory");
    }
  }
};
constexpr int NA_NUL = BATCH * 8 * (ROWS / 4), NA_NUC = BATCH * 8 * (CTX / 256);
__device__ __forceinline__ void na_phase(const Params& p, int first, int stride, unsigned* ctr, int dyn0, LAS unsigned char* lds, const int wave_s) {
  constexpr int NUL = NA_NUL, NUC = NA_NUC;
  const float scale = 0.08838834764831845f;
  for (int unit = first;; unit = ctr ? -1 : unit + stride) {
    __syncthreads();
    if (unit < 0) {
      volatile LAS int* slot = (volatile LAS int*)(lds + att::LDS_ATT);
      if (fresh_tid(wave_s) == 0) *slot = dyn0 + (int)__hip_atomic_fetch_add(ctr, 1u, __ATOMIC_RELAXED, __HIP_MEMORY_SCOPE_AGENT);
      __syncthreads();
      unit = __builtin_amdgcn_readfirstlane(*slot);
    }
    if (unit >= NUL + NUC) break;
    if (unit < NUL) {
      const int u = unit % (ROWS / 4), h = (unit / (ROWS / 4)) % 8, b = unit / ((ROWS / 4) * 8);
      const int kr_lo = clampi(4 * u - 4, 0, ROWS - 8);
      LAS float* tab = (LAS float*)(lds + att::OFF_TAB);
      { const int tid = fresh_tid(wave_s); if (tid < 465) tab[tid] = p.na_rpb[h * 465 + tid] * (1.0f / scale); }
      const long m0 = (long)b * SEQ + u * 256;
      NaSrc src{p.QKV0 + h * 128, b, kr_lo, 12};
      att::attn_body<false, true, 0, 3072, 3072, 2048>(p.QKV0 + m0 * 3072 + h * 128, src, NaBias{tab, u, kr_lo}, 16, scale,
                                                    p.YALL + m0 * 2048 + h * 128, p.G0 + m0 * 2048 + h * 128, (LAS char*)lds, wave_s);
    } else {
      const int uc = unit - NUL, qb = uc % (CTX / 256), h = (uc / (CTX / 256)) % 8, b = uc / ((CTX / 256) * 8);
      const long m0 = ML + (long)b * CTX + qb * 256;
      NaSrc src{p.QKV0 + h * 128, b, 0, 0};
      att::attn_body<false, false, 2, 3072, 3072, 2048>(p.QKV0 + m0 * 3072 + h * 128, src, att::NoBias{}, CTX / 64, scale,
                                                     p.YALL + m0 * 2048 + h * 128, p.G0 + m0 * 2048 + h * 128, (LAS char*)lds, wave_s);
    }
  }
}


constexpr int RW_TB = 32, RW_SLOT = 48, RW_BUF = RW_TB * 16 * RW_SLOT, RW_VOFF = 2 * RW_BUF, RW_VBUF = RW_TB * 32 * 2;
typedef unsigned u32x2 __attribute__((ext_vector_type(2)));
typedef _Float16 h8 __attribute__((ext_vector_type(8)));
typedef _Float16 h4 __attribute__((ext_vector_type(4)));
__device__ __forceinline__ float mix_lo(float a, unsigned h2, float c) { float d; asm("v_fma_mix_f32 %0, %1, %2, %3 op_sel_hi:[0,1,0]" : "=v"(d) : "v"(a), "v"(h2), "v"(c)); return d; }
__device__ __forceinline__ float mix_hi(float a, unsigned h2, float c) { float d; asm("v_fma_mix_f32 %0, %1, %2, %3 op_sel:[0,1,0] op_sel_hi:[0,1,0]" : "=v"(d) : "v"(a), "v"(h2), "v"(c)); return d; }
__device__ __forceinline__ float mix_hi_nop(float a, unsigned h2, float c) { float d; asm("v_fma_mix_f32 %0, %1, %2, %3 op_sel:[0,1,0] op_sel_hi:[0,1,0]\n\ts_nop 1" : "=v"(d) : "v"(a), "v"(h2), "v"(c)); return d; }
__device__ __forceinline__ float row_allreduce16(float x) {
  x += __builtin_bit_cast(float, __builtin_amdgcn_update_dpp(0, __builtin_bit_cast(int, x), 0x128, 0xf, 0xf, false));
  x += __builtin_bit_cast(float, __builtin_amdgcn_update_dpp(0, __builtin_bit_cast(int, x), 0x124, 0xf, 0xf, false));
  x += __builtin_bit_cast(float, __builtin_amdgcn_update_dpp(0, __builtin_bit_cast(int, x), 0x122, 0xf, 0xf, false));
  x += __builtin_bit_cast(float, __builtin_amdgcn_update_dpp(0, __builtin_bit_cast(int, x), 0x121, 0xf, 0xf, false));
  return x;
}
__device__ __forceinline__ long rw_row(int d, int b, int g) { return seq_row(d, b, g); }
__device__ __forceinline__ void rwkv_scan_phase(const Params& p, int bid, int nb, LAS unsigned char* lds, const int wave_s) {
  constexpr int NBLK = (CTX + SEQ) / RW_TB, NCH = 5 * RW_TB * 8 + RW_TB * 4, NIT = (NCH + NT - 1) / NT;
  for (int unit = bid; unit < 2 * 16 * BATCH * 2; unit += nb) {
    const int tid = fresh_tid(wave_s), lane = tid & 63;
    const int half = unit & 1, scan = unit >> 1, h = scan % 16, b = (scan / 16) % BATCH, d = scan / (16 * BATCH);
    const int rowl = wave_s * 4 + (lane >> 4), kg = lane & 15;
    float S0 = 0.f, S1 = 0.f, S2 = 0.f, S3 = 0.f;
    u32x4 st[NIT];
    __syncthreads();
    auto gload = [&](int blk) {
#pragma unroll
      for (int it = 0; it < NIT; ++it) {
        const int c = tid + it * NT;
        if (c < 5 * RW_TB * 8) {
          const int a = c / (RW_TB * 8), sidx = (c % (RW_TB * 8)) >> 3, part = c & 7;
          const int aidx = ((0x05237 >> (4 * a)) & 15) + (((0x0B >> a) & 1) ? d : 0);
          st[it] = *(const u32x4*)(p.R + (long)aidx * M * 1024 + rw_row(d, b, blk * RW_TB + sidx) * 1024 + h * 64 + part * 8);
        } else if (c < NCH) {
          const int c2 = c - 5 * RW_TB * 8, sidx = c2 >> 2, part = c2 & 3;
          st[it] = *(const u32x4*)(p.V + rw_row(d, b, blk * RW_TB + sidx) * 1024 + h * 64 + half * 32 + part * 8);
        }
      }
    };
    auto lwrite = [&](int buf) {
#pragma unroll
      for (int it = 0; it < NIT; ++it) {
        const int c = tid + it * NT;
        if (c < 5 * RW_TB * 8) {
          const int a = c / (RW_TB * 8), sidx = (c % (RW_TB * 8)) >> 3, part = c & 7;
          LAS unsigned char* dst = lds + buf * RW_BUF + (sidx * 16 + 2 * part) * RW_SLOT + a * 8;
          *(LAS u32x2*)(dst) = (u32x2){st[it].x, st[it].y};
          *(LAS u32x2*)(dst + RW_SLOT) = (u32x2){st[it].z, st[it].w};
        } else if (c < NCH) {
          const int c2 = c - 5 * RW_TB * 8, sidx = c2 >> 2, part = c2 & 3;
          *(LAS u32x4*)(lds + RW_VOFF + buf * RW_VBUF + (sidx * 32 + part * 8) * 2) = st[it];
        }
      }
    };
    gload(0);
    lwrite(0);
    __syncthreads();
    LAS f16* ybuf = (LAS f16*)(lds + RW_VOFF + 2 * RW_VBUF);
    auto yflush = [&](int blk) {
      if (tid < RW_TB * 4) {
        const int sidx = tid >> 2, part = tid & 3;
        const u32x4 v = *(const LAS u32x4*)(ybuf + (blk & 1) * RW_TB * 32 + sidx * 32 + part * 8);
        *(u32x4*)(p.Yd + (long)d * M * 1024 + rw_row(d, b, blk * RW_TB + sidx) * 1024 + h * 64 + half * 32 + part * 8) = v;
      }
    };
    for (int blk = 0; blk < NBLK; ++blk) {
      const int buf = blk & 1;
      if (blk + 1 < NBLK) gload(blk + 1);
      if (blk > 0) yflush(blk - 1);
      const LAS unsigned char* sl = lds + buf * RW_BUF + kg * RW_SLOT;
      const LAS f16* vb = (const LAS f16*)(lds + RW_VOFF + buf * RW_VBUF) + rowl;
      LAS f16* yb = ybuf + buf * RW_TB * 32 + rowl;
      u32x4 q0n = *(const LAS u32x4*)(sl), q1n = *(const LAS u32x4*)(sl + 16);
      u32x2 q2n = *(const LAS u32x2*)(sl + 32);
      f16 vvn = vb[0];
#pragma unroll 4
      for (int s2 = 0; s2 < RW_TB; ++s2) {
        const u32x4 q0 = q0n, q1 = q1n; const u32x2 q2 = q2n; const float vv = (float)vvn;
        const int sn = (s2 + 1 < RW_TB) ? s2 + 1 : s2;
        const LAS unsigned char* sp = sl + sn * 16 * RW_SLOT;
        q0n = *(const LAS u32x4*)(sp); q1n = *(const LAS u32x4*)(sp + 16); q2n = *(const LAS u32x2*)(sp + 32);
        vvn = vb[sn * 32];
        float sa = mix_lo(S0, q1.x, 0.f);
        sa = mix_hi(S1, q1.x, sa); sa = mix_lo(S2, q1.y, sa); sa = mix_hi_nop(S3, q1.y, sa);
        sa = row_allreduce16(sa);
        S0 = mix_lo(S0, q0.x, S0); S1 = mix_hi(S1, q0.x, S1); S2 = mix_lo(S2, q0.y, S2); S3 = mix_hi(S3, q0.y, S3);
        S0 = mix_lo(sa, q1.z, S0); S1 = mix_hi(sa, q1.z, S1); S2 = mix_lo(sa, q1.w, S2); S3 = mix_hi(sa, q1.w, S3);
        S0 = mix_lo(vv, q0.z, S0); S1 = mix_hi(vv, q0.z, S1); S2 = mix_lo(vv, q0.w, S2); S3 = mix_hi(vv, q0.w, S3);
        float y = mix_lo(S0, q2.x, 0.f);
        y = mix_hi(S1, q2.x, y); y = mix_lo(S2, q2.y, y); y = mix_hi_nop(S3, q2.y, y);
        y = row_allreduce16(y);
        yb[s2 * 32] = (f16)y;
      }
      if (blk + 1 < NBLK) lwrite(buf ^ 1);
      __syncthreads();
    }
    yflush(NBLK - 1);
  }
}


typedef __attribute__((ext_vector_type(8))) short hb8;
typedef __attribute__((ext_vector_type(4))) short hb4;
__device__ __forceinline__ hb8 join4(hb4 lo, hb4 hi) { return (hb8){lo[0], lo[1], lo[2], lo[3], hi[0], hi[1], hi[2], hi[3]}; }
typedef __bf16 nbf2 __attribute__((ext_vector_type(2)));
typedef float nf2 __attribute__((ext_vector_type(2)));
__device__ __forceinline__ unsigned cvt2(float lo, float hi) { return __builtin_bit_cast(unsigned, __builtin_convertvector((nf2){lo, hi}, nbf2)); }
__device__ __forceinline__ hb8 pack_acc(f32x4 t0, f32x4 t1) {
  u32x4 w = {cvt2(t0[0], t0[1]), cvt2(t0[2], t0[3]), cvt2(t1[0], t1[1]), cvt2(t1[2], t1[3])};
  return __builtin_bit_cast(hb8, w);
}
template <int V> struct ITag { static constexpr int v = V; };
__device__ __forceinline__ void hg_scan_phase(const Params& p, int unit0, int ustride, LAS unsigned char* lds, const int wave_s) {
  constexpr int NCHUNK = (CTX + SEQ) / HG_C;
  for (int unit4 = unit0; unit4 < 2 * BATCH * 8 * 2; unit4 += ustride) {
    const int tid = fresh_tid(wave_s), lane = tid & 63, l15 = lane & 15, g4 = lane >> 4;
    const int unit = unit4 >> 1, eq = unit4 & 1;
    const int h = unit % 8, b = (unit / 8) % BATCH, d = unit / (8 * BATCH);
    const int dd = 32 * (wave_s & 3) + (lane & 31), hf = lane >> 5;
    const bf16* fsrc = p.HGF + (long)d * M * 1024;
    const int es = eq * 64 + (wave_s & 3) * 16;
    f32x4 S[8];
#pragma unroll
    for (int t = 0; t < 8; ++t) S[t] = (f32x4){0.f, 0.f, 0.f, 0.f};
    u32x4 wq[2], wf[2], wv[2];
    const long rstep = d ? -1024 : 1024;
    auto pload = [&](int c) {
      const long r0 = seq_row(d, b, c * HG_C + (d ? HG_C - 1 : 0));
      const size_t o = ((size_t)(r0 >> 5) * 1024 + h * 128 + dd) * 32 + (d ? 1 - hf : hf) * 16;
      const u32x4* q = (const u32x4*)(p.HGQ + o); const u32x4* v = (const u32x4*)(p.HGI + o); const u32x4* f = (const u32x4*)(fsrc + o);
      wq[0] = q[0]; wq[1] = q[1]; wv[0] = v[0]; wv[1] = v[1]; wf[0] = f[0]; wf[1] = f[1];
    };
    auto prep = [&](int c, auto dirtag) {
      constexpr int DIR = decltype(dirtag)::v;
      LAS unsigned char* base = lds + (c & 1) * HG_LDS;
      LAS bf16* QI = (LAS bf16*)(base + HG_OFF_QI); LAS bf16* KI = (LAS bf16*)(base + HG_OFF_KI);
      LAS bf16* KET = (LAS bf16*)(base + HG_OFF_KET); LAS bf16* VT = (LAS bf16*)(base + HG_OFF_VT); LAS float* DEC = (LAS float*)(base + HG_OFF_DEC);
      float qv[16], kk[16], vv[16], bl[16];
      float run = 1.f;
#define HG_EL(w, j) (((j) & 1) ? __uint_as_float((w)[(j) >> 3][((j) >> 1) & 3] & 0xffff0000u) : __uint_as_float((w)[(j) >> 3][((j) >> 1) & 3] << 16))
#pragma unroll
      for (int r = 0; r < 16; ++r) {
        const int j = DIR ? 15 - r : r;
        qv[r] = HG_EL(wq, j); vv[r] = HG_EL(wv, j);
        kk[r] = HG_EL(wf, j);
        run *= 1.0f - kk[r];
        bl[r] = run;
      }
      __builtin_amdgcn_sched_barrier(0);
      pload(c + 1 < NCHUNK ? c + 1 : NCHUNK - 1);
      __builtin_amdgcn_sched_barrier(0);
      const float oth = __shfl_xor(run, 32);
      const float pre = hf ? oth : 1.f, tot = run * oth;
      unsigned ke[8], vt[8];
#pragma unroll
      for (int r = 0; r < 16; r += 2) {
        const float p0 = pre * bl[r], p1 = pre * bl[r + 1];
        const float i0v = __builtin_amdgcn_rcpf(p0), i1v = __builtin_amdgcn_rcpf(p1);
        const int i0 = hf * 16 + r;
        if (c >= CTX / HG_C) {
          QI[i0 * HG_LDQ + dd] = f2bf(qv[r] * p0); QI[(i0 + 1) * HG_LDQ + dd] = f2bf(qv[r + 1] * p1);
          KI[i0 * HG_LDQ + dd] = f2bf(kk[r] * i0v); KI[(i0 + 1) * HG_LDQ + dd] = f2bf(kk[r + 1] * i1v);
        }
        ke[r >> 1] = cvt2(kk[r] * (tot * i0v), kk[r + 1] * (tot * i1v));
        vt[r >> 1] = cvt2(vv[r], vv[r + 1]);
      }
      *(LAS u32x4*)(KET + dd * HG_LDT + hf * 16) = (u32x4){ke[0], ke[1], ke[2], ke[3]};
      *(LAS u32x4*)(KET + dd * HG_LDT + hf * 16 + 8) = (u32x4){ke[4], ke[5], ke[6], ke[7]};
      *(LAS u32x4*)(VT + dd * HG_LDT + hf * 16) = (u32x4){vt[0], vt[1], vt[2], vt[3]};
      *(LAS u32x4*)(VT + dd * HG_LDT + hf * 16 + 8) = (u32x4){vt[4], vt[5], vt[6], vt[7]};
      if (hf == 0) DEC[dd] = tot;
    };
    const bool prepw = wave_s >= 4, mma = wave_s < 4;
    __syncthreads();
    if (prepw) { pload(0); if (d) prep(0, ITag<1>{}); else prep(0, ITag<0>{}); }
    __syncthreads();
    if (prepw) {
      if (d) { for (int c = 0; c < NCHUNK; ++c) { if (c + 1 < NCHUNK) prep(c + 1, ITag<1>{}); WG_BAR_LDS(); } }
      else { for (int c = 0; c < NCHUNK; ++c) { if (c + 1 < NCHUNK) prep(c + 1, ITag<0>{}); WG_BAR_LDS(); } }
    } else if (!mma) {
      for (int c = 0; c < NCHUNK; ++c) WG_BAR_LDS();
    } else {
    for (int c = 0; c < NCHUNK; ++c) {
      LAS unsigned char* base = lds + (c & 1) * HG_LDS;
      const LAS bf16* QI = (const LAS bf16*)(base + HG_OFF_QI); const LAS bf16* KI = (const LAS bf16*)(base + HG_OFF_KI);
      const LAS bf16* KET = (const LAS bf16*)(base + HG_OFF_KET); const LAS bf16* VT = (const LAS bf16*)(base + HG_OFF_VT); const LAS float* DEC = (const LAS float*)(base + HG_OFF_DEC);
      {
      if (c >= CTX / HG_C) {
      f32x4 T00 = {0.f, 0.f, 0.f, 0.f}, T01 = T00, T11 = T00;
#pragma unroll
      for (int ks = 0; ks < 4; ++ks) {
        const hb8 a0 = *(const LAS hb8*)(KI + l15 * HG_LDQ + ks * 32 + g4 * 8);
        const hb8 a1 = *(const LAS hb8*)(KI + (16 + l15) * HG_LDQ + ks * 32 + g4 * 8);
        const hb8 b0 = *(const LAS hb8*)(QI + l15 * HG_LDQ + ks * 32 + g4 * 8);
        const hb8 b1 = *(const LAS hb8*)(QI + (16 + l15) * HG_LDQ + ks * 32 + g4 * 8);
        T00 = __builtin_amdgcn_mfma_f32_16x16x32_bf16(a0, b0, T00, 0, 0, 0);
        T01 = __builtin_amdgcn_mfma_f32_16x16x32_bf16(a0, b1, T01, 0, 0, 0);
        T11 = __builtin_amdgcn_mfma_f32_16x16x32_bf16(a1, b1, T11, 0, 0, 0);
      }
#pragma unroll
      for (int r = 0; r < 4; ++r) { if (4 * g4 + r > l15) { T00[r] = 0.f; T11[r] = 0.f; } }
      f32x4 O0 = {0.f, 0.f, 0.f, 0.f}, O1 = O0;
      {
        const hb4 vlo = *(const LAS hb4*)(VT + (es + l15) * HG_LDT + 4 * g4);
        const hb4 vhi = *(const LAS hb4*)(VT + (es + l15) * HG_LDT + 16 + 4 * g4);
        const hb8 bv = join4(vlo, vhi);
        const f32x4 Z = {0.f, 0.f, 0.f, 0.f};
        O0 = __builtin_amdgcn_mfma_f32_16x16x32_bf16(pack_acc(T00, Z), bv, O0, 0, 0, 0);
        O1 = __builtin_amdgcn_mfma_f32_16x16x32_bf16(pack_acc(T01, T11), bv, O1, 0, 0, 0);
      }
#pragma unroll
      for (int ks = 0; ks < 4; ++ks) {
        const hb8 sb = pack_acc(S[2 * ks], S[2 * ks + 1]);
        const hb8 q0 = join4(*(const LAS hb4*)(QI + l15 * HG_LDQ + ks * 32 + 4 * g4), *(const LAS hb4*)(QI + l15 * HG_LDQ + ks * 32 + 16 + 4 * g4));
        const hb8 q1 = join4(*(const LAS hb4*)(QI + (16 + l15) * HG_LDQ + ks * 32 + 4 * g4), *(const LAS hb4*)(QI + (16 + l15) * HG_LDQ + ks * 32 + 16 + 4 * g4));
        O0 = __builtin_amdgcn_mfma_f32_16x16x32_bf16(q0, sb, O0, 0, 0, 0);
        O1 = __builtin_amdgcn_mfma_f32_16x16x32_bf16(q1, sb, O1, 0, 0, 0);
      }
        f16* ob = p.O1d + (long)d * ML * 1024 + h * 128 + es + l15 + seq_row(d, b, c * HG_C + 4 * g4) * 1024;
#pragma unroll
        for (int r = 0; r < 4; ++r) {
          ob[r * rstep] = (f16)O0[r];
          ob[(16 + r) * rstep] = (f16)O1[r];
        }
      }
      {
        const hb8 bv = *(const LAS hb8*)(VT + (es + l15) * HG_LDT + g4 * 8);
#pragma unroll
        for (int t = 0; t < 8; ++t) {
          const f32x4 dc = *(const LAS f32x4*)(DEC + 16 * t + 4 * g4);
          const hb8 a = *(const LAS hb8*)(KET + (16 * t + l15) * HG_LDT + g4 * 8);
          S[t] = __builtin_amdgcn_mfma_f32_16x16x32_bf16(a, bv, S[t] * dc, 0, 0, 0);
        }
      }
      }
      WG_BAR_LDS();
    }
    }
  }
}


typedef float f32x8v __attribute__((ext_vector_type(8)));
__device__ __forceinline__ float xsum(float v, int width) {
  for (int o = 1; o < width; o <<= 1) v += __shfl_xor(v, o);
  return v;
}
__device__ __forceinline__ void ld8bf(const bf16* p, float* o) {
  const u32x4 w = *(const u32x4*)p;
  o[0] = __uint_as_float(w.x << 16); o[1] = __uint_as_float(w.x & 0xffff0000u); o[2] = __uint_as_float(w.y << 16); o[3] = __uint_as_float(w.y & 0xffff0000u);
  o[4] = __uint_as_float(w.z << 16); o[5] = __uint_as_float(w.z & 0xffff0000u); o[6] = __uint_as_float(w.w << 16); o[7] = __uint_as_float(w.w & 0xffff0000u);
}
__device__ __forceinline__ void st8bf(bf16* p, const float* v) {
  u32x4 w; w.x = pk2(v[0], v[1]); w.y = pk2(v[2], v[3]); w.z = pk2(v[4], v[5]); w.w = pk2(v[6], v[7]);
  *(u32x4*)p = w;
}
__device__ __forceinline__ void ld8h(const f16* p, float* o) {
  const h8 w = *(const h8*)p;
#pragma unroll
  for (int j = 0; j < 8; ++j) o[j] = (float)w[j];
}
__device__ __forceinline__ void st8h(f16* p, const float* v) {
  h8 w;
#pragma unroll
  for (int j = 0; j < 8; ++j) w[j] = (f16)v[j];
  *(h8*)p = w;
}
__device__ __forceinline__ void ld8f(const float* p, float* o) {
  const f32x4 a = *(const f32x4*)p, b = *(const f32x4*)(p + 4);
  o[0] = a[0]; o[1] = a[1]; o[2] = a[2]; o[3] = a[3]; o[4] = b[0]; o[5] = b[1]; o[6] = b[2]; o[7] = b[3];
}
__device__ __forceinline__ void adaln_phase(const Params& p, int bid, int nb, LAS unsigned char* lds, int tid) {
  LAS float* sc = (LAS float*)lds;
  LAS float* red = sc + NMOD * D;
  bool have = false;
  for (int item = bid; item < 2 * (D3 / 64); item += nb) {
    if (!have) {
      for (int i = tid; i < NMOD * D; i += NT) { const int r = i / D, k = i % D; const float cv = r < BATCH ? p.c[r * D + k] : p.c_ctx[k]; sc[i] = cv / (1.0f + __expf(-cv)); }
      have = true;
    }
    __syncthreads();
    const int l = item / (D3 / 64), j = (item % (D3 / 64)) * 64 + (tid & 63), kg = tid >> 6;
    const float* w = p.ada_w + (size_t)l * D * D3 + j;
    float acc[NMOD];
#pragma unroll
    for (int r = 0; r < NMOD; ++r) acc[r] = 0.f;
#pragma unroll 8
    for (int k = kg * (D / 8); k < (kg + 1) * (D / 8); ++k) {
      const float wv = w[(size_t)k * D3];
#pragma unroll
      for (int r = 0; r < NMOD; ++r) acc[r] = fmaf(sc[r * D + k], wv, acc[r]);
    }
#pragma unroll
    for (int r = 0; r < NMOD; ++r) red[(kg * NMOD + r) * 64 + (tid & 63)] = acc[r];
    __syncthreads();
    if (tid < NMOD * 64) {
      const int r = tid / 64, jj = tid & 63;
      float sum = p.ada_b[l * D3 + (item % (D3 / 64)) * 64 + jj];
#pragma unroll
      for (int q = 0; q < 8; ++q) sum += red[(q * NMOD + r) * 64 + jj];
      p.mod[((size_t)l * NMOD + r) * D3 + (item % (D3 / 64)) * 64 + jj] = sum;
    }
  }
}
__device__ __forceinline__ void normmod_phase(const Params& p, int l, int gw, int ngw, int lane, int m_first = 0) {
  for (int m = m_first + gw; m < M; m += ngw) {
    const float* src; int r;
    if (m < ML) { src = p.x + (size_t)m * D; r = m / SEQ; }
    else { src = (l == 0 ? p.ctx : p.XC1) + (size_t)(m - ML) * D; r = BATCH; }
    float v[D / 512][8]; float ss = 0.f;
#pragma unroll
    for (int q = 0; q < D / 512; ++q) {
      if (l == 1 && m < ML) ld8bf(p.X1b + (size_t)m * D + q * 512 + lane * 8, v[q]); else ld8f(src + q * 512 + lane * 8, v[q]);
#pragma unroll
      for (int j = 0; j < 8; ++j) ss = fmaf(v[q][j], v[q][j], ss); }
    const float rstd = 1.0f / sqrtf(xsum(ss, 64) / D + NORM_EPS);
    const float* md = p.mod + ((size_t)l * NMOD + r) * D3; const float* nw = p.norm_w + l * D;
#pragma unroll
    for (int q = 0; q < D / 512; ++q) { const int k0 = q * 512 + lane * 8; float nv[8], sh[8], sl[8], o[8];
      ld8f(nw + k0, nv); ld8f(md + k0, sh); ld8f(md + D + k0, sl);
#pragma unroll
      for (int j = 0; j < 8; ++j) o[j] = v[q][j] * rstd * nv[j] * (1.0f + sl[j]) + sh[j];
      st8bf(p.H + (size_t)m * D + k0, o); }
  }
}
__device__ __forceinline__ void final_phase(const Params& p, int gw, int ngw, int lane) {
  for (int m = gw; m < ML; m += ngw) {
    float* x = p.out + (size_t)m * D;
    float v[D / 512][8]; float ss = 0.f;
#pragma unroll
    for (int q = 0; q < D / 512; ++q) { ld8bf(p.X2b + (size_t)m * D + q * 512 + lane * 8, v[q]);
#pragma unroll
      for (int j = 0; j < 8; ++j) ss = fmaf(v[q][j], v[q][j], ss); }
    const float rstd = 1.0f / sqrtf(xsum(ss, 64) / D + NORM_EPS);
#pragma unroll
    for (int q = 0; q < D / 512; ++q) { const int k0 = q * 512 + lane * 8; float nv[8];
      ld8f(p.final_norm_w + k0, nv);
      f32x4 a = {v[q][0] * rstd * nv[0], v[q][1] * rstd * nv[1], v[q][2] * rstd * nv[2], v[q][3] * rstd * nv[3]};
      f32x4 b = {v[q][4] * rstd * nv[4], v[q][5] * rstd * nv[5], v[q][6] * rstd * nv[6], v[q][7] * rstd * nv[7]};
      *(f32x4*)(x + k0) = a; *(f32x4*)(x + k0 + 4) = b; }
  }
}
__device__ __forceinline__ void rwkv_out_phase(const Params& p, int bid, int nb, int tid) {
  for (long it = (long)bid * NT + tid; it < (long)M * 16 * 8; it += (long)nb * NT) {
    const long mh = it >> 3; const int sub = (int)(it & 7); const long m = mh >> 4; const int h = (int)(mh & 15);
    const int c = h * 64 + sub * 8; const long o1 = m * 1024 + c, o2 = (long)M * 1024 + o1;
    float y0[8], y1[8], vv[8];
    ld8h(p.Yd + o1, y0); ld8h(p.Yd + o2, y1); ld8h(p.V + o1, vv);
    const float bon = p.KN[mh];
    float s = 0.f;
#pragma unroll
    for (int j = 0; j < 8; ++j) { y0[j] += y1[j]; s += y0[j]; }
    const float mu = xsum(s, 8) * (1.0f / 64);
    float q = 0.f;
#pragma unroll
    for (int j = 0; j < 8; ++j) { y0[j] -= mu; q = fmaf(y0[j], y0[j], q); }
    const float rs = 1.0f / sqrtf(xsum(q, 8) * (1.0f / 64) + 64e-5f);
    float lw[8], lbv[8], gt[8], o[8];
    ld8f(p.rw_ln_w + c, lw); ld8f(p.rw_ln_b + c, lbv); ld8bf(p.G0 + m * 2048 + 1024 + c, gt);
#pragma unroll
    for (int j = 0; j < 8; ++j) o[j] = (y0[j] * rs * lw[j] + lbv[j] + bon * vv[j]) * gt[j];
    st8bf(p.YALL + m * 2048 + 1024 + c, o);
  }
}
__device__ __forceinline__ void hg_out_phase(const Params& p, int bid, int nb, int tid) {
  for (long it = (long)bid * NT + tid; it < (long)ML * 8 * 16; it += (long)nb * NT) {
    const long mh = it >> 4; const int sub = (int)(it & 15); const long m = mh >> 3; const int h = (int)(mh & 7);
    const int c = h * 128 + sub * 8; const long o1 = m * 1024 + c, o2 = (long)ML * 1024 + o1;
    float a[8], b2[8], w[8], gt[8], o[8];
    ld8h(p.O1d + o1, a); ld8h(p.O1d + o2, b2);
    float ss = 0.f;
#pragma unroll
    for (int j = 0; j < 8; ++j) { a[j] += b2[j]; ss = fmaf(a[j], a[j], ss); }
    const float rstd = 1.0f / sqrtf(xsum(ss, 16) * (1.0f / 128) + NORM_EPS);
    ld8f(p.hg_norm_w + sub * 8, w); ld8bf(p.G1 + m * 2048 + 1024 + c, gt);
#pragma unroll
    for (int j = 0; j < 8; ++j) o[j] = a[j] * rstd * w[j] * gt[j];
    st8bf(p.YALL + m * 2048 + 1024 + c, o);
  }
}
__device__ __forceinline__ void mla_prep_phase(const Params& p, int gw, int ngw, int lane) {
  for (int m = gw; m < M; m += ngw) {
    const bf16* z = p.CQKV + (size_t)m * 1088;
    float q[8], kv[8], w[8], o[8];
    ld8bf(z + lane * 8, q); ld8bf(z + 512 + lane * 8, kv);
    float sq = 0.f, sk = 0.f;
#pragma unroll
    for (int j = 0; j < 8; ++j) { sq = fmaf(q[j], q[j], sq); sk = fmaf(kv[j], kv[j], sk); }
    const float rq = 1.0f / sqrtf(xsum(sq, 64) * (1.0f / 512) + NORM_EPS), rk = 1.0f / sqrtf(xsum(sk, 64) * (1.0f / 512) + NORM_EPS);
    if (m < ML) { ld8f(p.mla_q_norm + lane * 8, w);
#pragma unroll
      for (int j = 0; j < 8; ++j) o[j] = q[j] * rq * w[j];
      st8bf(p.CQN + (size_t)m * 512 + lane * 8, o); }
    ld8f(p.mla_kv_norm + lane * 8, w);
#pragma unroll
    for (int j = 0; j < 8; ++j) o[j] = kv[j] * rk * w[j];
    st8bf(p.CKVN + (size_t)m * 512 + lane * 8, o);
    if (lane < 8) {
      float x[8]; ld8bf(z + 1024 + lane * 8, x);
      if (m < ML) {
        const float* rt = p.ROPE + ((size_t)(m % SEQ) * 32 + lane * 4) * 2;
        float cs[8]; ld8f(rt, cs);
#pragma unroll
        for (int j = 0; j < 4; ++j) { const float x0 = x[2 * j], x1 = x[2 * j + 1]; x[2 * j] = x0 * cs[2 * j] - x1 * cs[2 * j + 1]; x[2 * j + 1] = x0 * cs[2 * j + 1] + x1 * cs[2 * j]; }
      }
      st8bf(p.KPE + (size_t)kvrow(m) * 64 + lane * 8, x);
    }
  }
}


__device__ __forceinline__ void shift8(const Params& p, int row, int c, float* out) {
  const bool lat = row < ML; const int t = lat ? row % SEQ : (row - ML) % CTX; const int tn = lat ? SEQ : CTX;
  float u[8], pv[8], nx[8], mp[8], mn[8];
  ld8bf(p.U0 + (size_t)row * 3328 + c, u);
  if (t > 0) ld8bf(p.U0 + (size_t)(row - 1) * 3328 + c, pv); else {
#pragma unroll
    for (int j = 0; j < 8; ++j) pv[j] = 0.f; }
  if (t < tn - 1) ld8bf(p.U0 + (size_t)(row + 1) * 3328 + c, nx); else {
#pragma unroll
    for (int j = 0; j < 8; ++j) nx[j] = 0.f; }
  ld8f(p.rw_mu + c, mp); ld8f(p.rw_mu + 3328 + c, mn);
#pragma unroll
  for (int j = 0; j < 8; ++j) out[j] = u[j] + mp[j] * (pv[j] - u[j]) + mn[j] * (nx[j] - u[j]);
}
__device__ __forceinline__ void rwkv_prep_phase(const Params& p, int bid, int nb, int tid) {
  for (long it = (long)bid * NT + tid; it < 4096L * 32; it += (long)nb * NT) {
    const int n = (int)(it >> 5), kg = (int)(it & 31), blk = n >> 10, c = n & 1023;
    float v[8];
#pragma unroll
    for (int j = 0; j < 8; ++j) v[j] = 0.f;
    if ((kg >> 3) == blk) {
      const float* W = (blk < 2 ? p.rw_w2 : p.rw_a2) + (size_t)(blk & 1) * 64 * 1024;
#pragma unroll
      for (int j = 0; j < 8; ++j) v[j] = W[(size_t)((kg & 7) * 8 + j) * 1024 + c];
    }
    st8bf(p.Btm + (size_t)n * 256 + kg * 8, v);
  }
}
__device__ __forceinline__ void rwkv_lr_phase(const Params& p, int bid, int nb, int tid) {
  for (long it = (long)bid * NT + tid; it < (long)M * 32; it += (long)nb * NT) {
    const int m = (int)(it >> 5), g = (int)(it & 31);
    float v[8]; shift8(p, m, 3072 + g * 8, v);
    if (g < 16) {
#pragma unroll
      for (int j = 0; j < 8; ++j) v[j] = 1.0f - 2.0f * __builtin_amdgcn_rcpf(1.0f + __expf(2.0f * v[j]));
    }
    st8bf(p.LRb + (size_t)m * 256 + g * 8, v);
  }
}

__device__ __forceinline__ void rwkv_fin_phase(const Params& p, int bid, int nb, int tid) {
  constexpr int RS = 8;
  for (long it = (long)bid * NT + tid; it < (long)(M / RS) * 16 * 8; it += (long)nb * NT) {
    const int sub = (int)(it & 7); const long sh = it >> 3; const int h = (int)(sh & 15); const int m0 = (int)(sh >> 4) * RS;
    const int c = h * 64 + sub * 8;
    float kkw[8], ka[8], rk[8], mp[3][8], mn[3][8];
    ld8f(p.rw_k_k + c, kkw); ld8f(p.rw_k_a + c, ka); ld8f(p.rw_r_k + c, rk);
#pragma unroll
    for (int q = 0; q < 3; ++q) { ld8f(p.rw_mu + q * 1024 + c, mp[q]); ld8f(p.rw_mu + 3328 + q * 1024 + c, mn[q]); }
    const bool lat = m0 < ML; const int t0 = lat ? m0 % SEQ : (m0 - ML) % CTX; const int tn = lat ? SEQ : CTX;
    float pv[3][8], cu[3][8], nx[3][8];
#pragma unroll
    for (int q = 0; q < 3; ++q) {
      if (t0 > 0) ld8bf(p.U0 + (size_t)(m0 - 1) * 3328 + q * 1024 + c, pv[q]); else {
#pragma unroll
        for (int j = 0; j < 8; ++j) pv[q][j] = 0.f; }
      ld8bf(p.U0 + (size_t)m0 * 3328 + q * 1024 + c, cu[q]);
    }
#pragma unroll
    for (int rr = 0; rr < RS; ++rr) {
      const int m = m0 + rr; const size_t o1 = (size_t)m * 1024 + c;
#pragma unroll
      for (int q = 0; q < 3; ++q) {
        if (t0 + rr < tn - 1) ld8bf(p.U0 + (size_t)(m + 1) * 3328 + q * 1024 + c, nx[q]); else {
#pragma unroll
          for (int j = 0; j < 8; ++j) nx[q][j] = 0.f; }
      }
      float r[8], k[8], v[8];
#pragma unroll
      for (int j = 0; j < 8; ++j) {
        r[j] = cu[0][j] + mp[0][j] * (pv[0][j] - cu[0][j]) + mn[0][j] * (nx[0][j] - cu[0][j]);
        k[j] = cu[1][j] + mp[1][j] * (pv[1][j] - cu[1][j]) + mn[1][j] * (nx[1][j] - cu[1][j]);
        v[j] = cu[2][j] + mp[2][j] * (pv[2][j] - cu[2][j]) + mn[2][j] * (nx[2][j] - cu[2][j]);
      }
      float kw[8], ss = 0.f;
#pragma unroll
      for (int j = 0; j < 8; ++j) { kw[j] = kkw[j] * k[j]; ss = fmaf(kw[j], kw[j], ss); }
      const float kn = 1.0f / fmaxf(sqrtf(xsum(ss, 8)), 1e-12f);
      float nk[8];
#pragma unroll
      for (int j = 0; j < 8; ++j) { kw[j] *= kn; nk[j] = -kw[j]; }
      st8h(p.R + o1, r); st8h(p.V + o1, v); st8h(p.KK + o1, nk);
      float bon = 0.f;
#pragma unroll
      for (int d = 0; d < 2; ++d) {
        const size_t o2 = (size_t)d * M * 1024 + o1;
        float a[8];
        ld8h(p.BB + o2, a);
#pragma unroll
        for (int j = 0; j < 8; ++j) bon = fmaf(r[j] * (k[j] * (1.0f + (a[j] - 1.0f) * ka[j])), rk[j], bon);
      }
      st8h(p.KD + o1, k);
      bon = xsum(bon, 8);
      if (sub == 0) p.KN[(size_t)m * 16 + h] = bon;
#pragma unroll
      for (int q = 0; q < 3; ++q)
#pragma unroll
        for (int j = 0; j < 8; ++j) { pv[q][j] = cu[q][j]; cu[q][j] = nx[q][j]; }
    }
  }
}
struct GEpiTermsP { const float *rw_w0, *rw_a0; f16 *DL, *BB; };
struct GEpiTerms {
  static constexpr bool PERM = true, AFTER_DRAIN = false;
  GEpiTermsP p;
  __device__ __forceinline__ void operator()(const f32x4 (&acc)[2][2][4][2], const pg8::Unit& u, int wr, int wc, int fr, int fq) const {
    const int blk = u.pn >> 2, d = blk & 1, cb = (u.pn & 3) * 256;
    const size_t doff = (size_t)d * M * 1024;
#pragma unroll
    for (int bj = 0; bj < 2; ++bj) {
      const int c = cb + bj * 128 + wc * 32 + 8 * fq;
      if (blk < 2) {
        float w0[8]; ld8f(p.rw_w0 + d * 1024 + c, w0);
#pragma unroll
        for (int ai = 0; ai < 2; ++ai)
#pragma unroll
          for (int m = 0; m < 4; ++m) {
            const int row = u.pm * 256 + ai * 128 + wr * 64 + m * 16 + fr;
            float o[8];
#pragma unroll
            for (int j = 0; j < 8; ++j) {
              const float w = w0[j] + (j < 4 ? acc[ai][bj][m][0][j] : acc[ai][bj][m][1][j - 4]);
              const float e = 0.60653065971263342f * __builtin_amdgcn_rcpf(1.0f + __expf(-w));
              o[j] = __expf(-e) - 1.0f;
            }
            st8h(p.DL + doff + (size_t)row * 1024 + c, o);
          }
      } else {
        float a0[8]; ld8f(p.rw_a0 + d * 1024 + c, a0);
#pragma unroll
        for (int ai = 0; ai < 2; ++ai)
#pragma unroll
          for (int m = 0; m < 4; ++m) {
            const int row = u.pm * 256 + ai * 128 + wr * 64 + m * 16 + fr;
            float o[8];
#pragma unroll
            for (int j = 0; j < 8; ++j) o[j] = __builtin_amdgcn_rcpf(1.0f + __expf(-(a0[j] + (j < 4 ? acc[ai][bj][m][0][j] : acc[ai][bj][m][1][j - 4]))));
            st8h(p.BB + doff + (size_t)row * 1024 + c, o);
          }
      }
    }
  }
};


__device__ __forceinline__ hb8 join4z(hb4 lo) { return (hb8){lo[0], lo[1], lo[2], lo[3], 0, 0, 0, 0}; }
__device__ __forceinline__ void rwkv_chunk_phase(const Params& p, int bid, int nb, LAS unsigned char* lds, const int wave_s) {
  constexpr int NCH = (CTX + SEQ) / RC;
  for (int unit = bid; unit < 2 * BATCH * 16; unit += nb) {
    const int tid = fresh_tid(wave_s), lane = tid & 63, l15 = lane & 15, g4 = lane >> 4;
    const int h = unit % 16, b = (unit / 16) % BATCH, d = unit / (16 * BATCH);
    LAS float* NBF = (LAS float*)(lds + RC_NBF);
    __syncthreads();
    for (int i = tid; i < (3 * RC_IMG + 2 * RC_MAT) / 4; i += NT) ((LAS unsigned*)lds)[i] = 0u;
    const int ka = 32 * (wave_s & 1) + (lane & 31), hs = lane >> 5;
    const f16* pDL = p.DL + (size_t)d * M * 1024 + h * 64 + ka; const f16* pKD = p.KD + h * 64 + ka; const f16* pBB = p.BB + (size_t)d * M * 1024 + h * 64 + ka;
    const float ka_l = p.rw_k_a[h * 64 + ka];
    const f16* pKK = p.KK + h * 64 + ka; const f16* pR = p.R + h * 64 + ka; const f16* pV = p.V + h * 64 + ka;
    f32x4 ST[4];
#pragma unroll
    for (int t = 0; t < 4; ++t) ST[t] = (f32x4){0.f, 0.f, 0.f, 0.f};
    f16 ndl[8], nkd[8], nbb[8], nkk[8], nr[8], nv[8];
    const long rstep = d ? -1024 : 1024;
    auto pload = [&](int c) {
      const long o0 = seq_row(d, b, c * RC + 8 * hs) * 1024;
#pragma unroll
      for (int q = 0; q < 8; ++q) { const long o = o0 + q * rstep; ndl[q] = pDL[o]; nkd[q] = pKD[o]; nbb[q] = pBB[o]; nkk[q] = pKK[o]; nr[q] = pR[o]; nv[q] = pV[o]; }
    };
    auto prepA = [&](int c) {
      LAS unsigned char* im = lds + (c % 3) * RC_IMG;
      LAS bf16* AT = (LAS bf16*)(im + RC_AT); LAS bf16* RT = (LAS bf16*)(im + RC_RT); LAS bf16* BT = (LAS bf16*)(im + RC_BT); LAS bf16* KT = (LAS bf16*)(im + RC_KT);
      LAS bf16* KH = (LAS bf16*)(im + RC_KH); LAS bf16* VT = (LAS bf16*)(im + RC_VT); LAS bf16* BH = (LAS bf16*)(im + RC_BH); LAS float* PC = (LAS float*)(im + RC_PC);
      float pr[8], av[8], bv[8], kv[8], rv[8], vv[8];
      float run = 1.f;
#pragma unroll
      for (int q = 0; q < 8; ++q) { run *= 1.0f + (float)ndl[q]; pr[q] = run; av[q] = (float)nkk[q]; const float ax = (float)nbb[q];
        bv[q] = -av[q] * ax; kv[q] = (float)nkd[q] * (1.0f + (ax - 1.0f) * ka_l); rv[q] = (float)nr[q]; vv[q] = (float)nv[q]; }
      __builtin_amdgcn_sched_barrier(0);
      pload(c + 1 < NCH ? c + 1 : NCH - 1);
      __builtin_amdgcn_sched_barrier(0);
      const float oth = __shfl_xor(run, 32);
      const float pre = hs ? oth : 1.f, tot = run * oth;
      unsigned bh[4], kh[4], vt[4];
#pragma unroll
      for (int q = 0; q < 8; ++q) {
        const int i = 8 * hs + q;
        const float Pi = pre * pr[q], Pm = q ? pre * pr[q - 1] : pre, inv = __builtin_amdgcn_rcpf(Pi);
        AT[i * RC_LD + ka] = f2bf(av[q] * Pm); RT[i * RC_LD + ka] = f2bf(rv[q] * Pi);
        bv[q] *= inv; kv[q] *= inv;
        BT[i * RC_LD + ka] = f2bf(bv[q]); KT[i * RC_LD + ka] = f2bf(kv[q]);
      }
#pragma unroll
      for (int q = 0; q < 4; ++q) { bh[q] = cvt2(bv[2 * q] * tot, bv[2 * q + 1] * tot); kh[q] = cvt2(kv[2 * q] * tot, kv[2 * q + 1] * tot); vt[q] = cvt2(vv[2 * q], vv[2 * q + 1]); }
      *(LAS u32x4*)(BH + ka * 16 + 8 * hs) = (u32x4){bh[0], bh[1], bh[2], bh[3]};
      *(LAS u32x4*)(KH + ka * RC_LDJ + 8 * hs) = (u32x4){kh[0], kh[1], kh[2], kh[3]};
      *(LAS u32x4*)(VT + ka * RC_LDJ + 8 * hs) = (u32x4){vt[0], vt[1], vt[2], vt[3]};
      if (hs == 0) PC[ka] = tot;
    };
    auto prepB = [&](int c) {
      LAS unsigned char* im = lds + (c % 3) * RC_IMG; LAS unsigned char* mt = lds + RC_MAT0 + (c & 1) * RC_MAT;
      LAS bf16* NKT = (LAS bf16*)(mt + RC_NKT); LAS bf16* MKT = (LAS bf16*)(mt + RC_MKT); LAS bf16* TT = (LAS bf16*)(mt + RC_TT); LAS bf16* MBT = (LAS bf16*)(mt + RC_MBT);
      const LAS bf16* AT = (const LAS bf16*)(im + RC_AT); const LAS bf16* RT = (const LAS bf16*)(im + RC_RT); const LAS bf16* BT = (const LAS bf16*)(im + RC_BT); const LAS bf16* KT = (const LAS bf16*)(im + RC_KT);
      const int fo = l15 * RC_LD + g4 * 8;
      if (wave_s == 4) {
        f32x4 D0 = {0.f, 0.f, 0.f, 0.f}, D1 = D0, D2 = D0;
#pragma unroll
        for (int ks = 0; ks < 2; ++ks) {
          const hb8 fa = *(const LAS hb8*)(AT + fo + ks * 32), fr = *(const LAS hb8*)(RT + fo + ks * 32), fb = *(const LAS hb8*)(BT + fo + ks * 32), fk = *(const LAS hb8*)(KT + fo + ks * 32);
          D0 = __builtin_amdgcn_mfma_f32_16x16x32_bf16(fa, fk, D0, 0, 0, 0);
          D1 = __builtin_amdgcn_mfma_f32_16x16x32_bf16(fr, fb, D1, 0, 0, 0);
          D2 = __builtin_amdgcn_mfma_f32_16x16x32_bf16(fr, fk, D2, 0, 0, 0);
        }
#pragma unroll
        for (int r = 0; r < 4; ++r) {
          const int i = 4 * g4 + r;
          NKT[i * RC_LDJ + l15] = f2bf(l15 < i ? D0[r] : 0.f);
          MBT[i * 16 + l15] = f2bf(l15 <= i ? D1[r] : 0.f);
          MKT[i * RC_LDJ + l15] = f2bf(l15 <= i ? D2[r] : 0.f);
        }
      } else {
        f32x4 Dm = {0.f, 0.f, 0.f, 0.f};
#pragma unroll
        for (int ks = 0; ks < 2; ++ks) Dm = __builtin_amdgcn_mfma_f32_16x16x32_bf16(*(const LAS hb8*)(AT + fo + ks * 32), *(const LAS hb8*)(BT + fo + ks * 32), Dm, 0, 0, 0);
#pragma unroll
        for (int r = 0; r < 4; ++r) { const int i = 4 * g4 + r; NBF[i * 20 + l15] = (l15 < i) ? Dm[r] : 0.f; }
        asm volatile("s_waitcnt lgkmcnt(0)" ::: "memory");
        f32x4 nrow[16][4];
#pragma unroll
        for (int i = 1; i < 16; ++i)
#pragma unroll
          for (int q4 = 0; q4 < 4; ++q4) if (4 * q4 < i) nrow[i][q4] = *(const LAS f32x4*)(NBF + i * 20 + 4 * q4);
        __builtin_amdgcn_sched_barrier(0);
        float t[16];
#pragma unroll
        for (int i = 0; i < 16; ++i) {
          float acc = (i == l15) ? 1.f : 0.f;
#pragma unroll
          for (int j = 0; j < i; ++j) acc = fmaf(t[j], nrow[i][j >> 2][j & 3], acc);
          t[i] = acc;
        }
        if (g4 == 0) {
#pragma unroll
          for (int i = 0; i < 16; ++i) TT[i * 16 + l15] = f2bf(t[i]);
        }
      }
    };
    auto stage2 = [&](int c) {
      LAS unsigned char* im = lds + (c % 3) * RC_IMG; LAS unsigned char* mt = lds + RC_MAT0 + (c & 1) * RC_MAT;
      const LAS bf16* AT = (const LAS bf16*)(im + RC_AT); const LAS bf16* RT = (const LAS bf16*)(im + RC_RT);
      const LAS bf16* KH = (const LAS bf16*)(im + RC_KH); const LAS bf16* VT = (const LAS bf16*)(im + RC_VT); const LAS bf16* BH = (const LAS bf16*)(im + RC_BH); const LAS float* PC = (const LAS float*)(im + RC_PC);
      const LAS bf16* NKT = (const LAS bf16*)(mt + RC_NKT); const LAS bf16* MKT = (const LAS bf16*)(mt + RC_MKT); const LAS bf16* TT = (const LAS bf16*)(mt + RC_TT); const LAS bf16* MBT = (const LAS bf16*)(mt + RC_MBT);
      const int vrow = wave_s * 16 + l15;
      const hb8 vfr = *(const LAS hb8*)(VT + vrow * RC_LDJ + g4 * 8);
      f32x4 Xt = {0.f, 0.f, 0.f, 0.f}, Yt = Xt;
#pragma unroll
      for (int ks = 0; ks < 2; ++ks) {
        const hb8 sb = pack_acc(ST[2 * ks], ST[2 * ks + 1]);
        const hb8 aa = join4(*(const LAS hb4*)(AT + l15 * RC_LD + ks * 32 + 4 * g4), *(const LAS hb4*)(AT + l15 * RC_LD + ks * 32 + 16 + 4 * g4));
        const hb8 ra = join4(*(const LAS hb4*)(RT + l15 * RC_LD + ks * 32 + 4 * g4), *(const LAS hb4*)(RT + l15 * RC_LD + ks * 32 + 16 + 4 * g4));
        Xt = __builtin_amdgcn_mfma_f32_16x16x32_bf16(aa, sb, Xt, 0, 0, 0);
        Yt = __builtin_amdgcn_mfma_f32_16x16x32_bf16(ra, sb, Yt, 0, 0, 0);
      }
      const f32x4 Zr = {0.f, 0.f, 0.f, 0.f};
      Xt = __builtin_amdgcn_mfma_f32_16x16x32_bf16(*(const LAS hb8*)(NKT + l15 * RC_LDJ + g4 * 8), vfr, Xt, 0, 0, 0);
      const f32x4 Sg = __builtin_amdgcn_mfma_f32_16x16x32_bf16(join4z(*(const LAS hb4*)(TT + l15 * 16 + 4 * g4)), pack_acc(Xt, Zr), Zr, 0, 0, 0);
      const hb8 sgb = pack_acc(Sg, Zr);
      Yt = __builtin_amdgcn_mfma_f32_16x16x32_bf16(join4z(*(const LAS hb4*)(MBT + l15 * 16 + 4 * g4)), sgb, Yt, 0, 0, 0);
      Yt = __builtin_amdgcn_mfma_f32_16x16x32_bf16(*(const LAS hb8*)(MKT + l15 * RC_LDJ + g4 * 8), vfr, Yt, 0, 0, 0);
#pragma unroll
      for (int t = 0; t < 4; ++t) {
        const f32x4 pc = *(const LAS f32x4*)(PC + 16 * t + 4 * g4);
        f32x4 acc = ST[t] * pc;
        acc = __builtin_amdgcn_mfma_f32_16x16x32_bf16(join4z(*(const LAS hb4*)(BH + (16 * t + l15) * 16 + 4 * g4)), sgb, acc, 0, 0, 0);
        ST[t] = __builtin_amdgcn_mfma_f32_16x16x32_bf16(*(const LAS hb8*)(KH + (16 * t + l15) * RC_LDJ + g4 * 8), vfr, acc, 0, 0, 0);
      }
      f16* yo = p.Yd + (size_t)d * M * 1024 + h * 64 + vrow + seq_row(d, b, c * RC + 4 * g4) * 1024;
#pragma unroll
      for (int r = 0; r < 4; ++r) yo[r * rstep] = (f16)Yt[r];
    };
    if (wave_s >= 6) pload(0);
    __syncthreads();
    if (wave_s < 4) {
      for (int c = -2; c < NCH; ++c) { if (c >= 0) stage2(c); WG_BAR_LDS(); }
    } else if (wave_s < 6) {
      for (int c = -2; c < NCH; ++c) { if (c + 1 >= 0 && c + 1 < NCH) prepB(c + 1); WG_BAR_LDS(); }
    } else {
      for (int c = -2; c < NCH; ++c) { if (c + 2 < NCH) prepA(c + 2); WG_BAR_LDS(); }
    }
  }
}


#define XB_TMO      128
#define XB_XCNT(j)  (256  + 64 * (j))
#define XB_XSUB(j)  (1280 + 64 * (j))
#define XB_XGEN(j)  (2304 + 64 * (j))
#define XB_TOP      3328
#define XB_TOPGEN   3392
#define XCD_BAR_WORDS 3456
#define NA_CTR_WORD 3600
#define XB_SPIN_CAP (1u << 18)
__device__ __forceinline__ unsigned xb_ld(unsigned* p)              { return __hip_atomic_load(p, __ATOMIC_RELAXED, __HIP_MEMORY_SCOPE_AGENT); }
__device__ __forceinline__ unsigned xb_add(unsigned* p, unsigned v) { return __hip_atomic_fetch_add(p, v, __ATOMIC_RELAXED, __HIP_MEMORY_SCOPE_AGENT); }
__device__ __forceinline__ unsigned xb_xcc_id() { return (unsigned)__builtin_amdgcn_s_getreg((3 << 11) | 20) & 0xFu; }
#define XB_SPIN(cond, bar) do { unsigned _sp = 0; while (cond) { __builtin_amdgcn_s_sleep(1); \
    if ((++_sp & 255u) == 0u) { if (xb_ld(&(bar)[XB_TMO])) break; if (_sp > XB_SPIN_CAP) { atomicAdd(&(bar)[XB_TMO], 1u); break; } } } } while (0)
struct XcdBarrier { unsigned* bar; unsigned x; volatile LAS unsigned* st; };
__device__ __forceinline__ XcdBarrier xcd_barrier_post(unsigned* bar, volatile LAS unsigned* st, bool t0) {
  XcdBarrier b; b.bar = bar; b.x = xb_xcc_id(); b.st = st;
  if (t0) (void)xb_add(&bar[XB_XCNT(b.x)], 1u);
  return b;
}
__device__ __forceinline__ void xcd_barrier_complete(unsigned* bar, unsigned x, unsigned& nloc, unsigned& nx) {
  const unsigned G = gridDim.x * gridDim.y * gridDim.z;
  unsigned sum, cnt, mine, sp = 0u;
  for (;;) {
    sum = 0u; cnt = 0u; mine = 0u;
#pragma unroll
    for (unsigned j = 0; j < 16; ++j) { const unsigned c = xb_ld(&bar[XB_XCNT(j)]); sum += c; cnt += (c > 0u) ? 1u : 0u; mine = (j == x) ? c : mine; }
    if (sum == G) break;
    __builtin_amdgcn_s_sleep(1);
    if ((++sp & 255u) == 0u) { if (xb_ld(&bar[XB_TMO])) break; if (sp > XB_SPIN_CAP) { atomicAdd(&bar[XB_TMO], 1u); break; } }
  }
  nloc = mine > 0u ? mine : 1u; nx = cnt > 0u ? cnt : 1u;
}
__device__ __forceinline__ void xcd_barrier(const XcdBarrier& b, bool t0) {
  asm volatile("s_waitcnt vmcnt(0)" ::: "memory");
  __syncthreads();
  if (t0) {
    unsigned* bar = b.bar;
    __builtin_amdgcn_s_waitcnt(0);
    unsigned nloc = b.st[0], nx = b.st[1];
    if (nloc == 0u) { xcd_barrier_complete(bar, b.x, nloc, nx); b.st[0] = nloc; b.st[1] = nx; }
    const unsigned old = xb_add(&bar[XB_XSUB(b.x)], 1u);
    const unsigned gen = old / nloc;
    if (old + 1u == (gen + 1u) * nloc) {
      __builtin_amdgcn_fence(__ATOMIC_RELEASE, "agent");
      asm volatile("s_waitcnt vmcnt(0)" ::: "memory");
      const unsigned og = xb_add(&bar[XB_TOP], 1u);
      const unsigned tg = og / nx;
      if (og + 1u == (tg + 1u) * nx) xb_add(&bar[XB_TOPGEN], 1u);
      else XB_SPIN(xb_ld(&bar[XB_TOPGEN]) == tg, bar);
      __builtin_amdgcn_fence(__ATOMIC_ACQUIRE, "agent");
      xb_add(&bar[XB_XGEN(b.x)], 1u);
      asm volatile("s_waitcnt vmcnt(0)" ::: "memory");
    } else {
      XB_SPIN(xb_ld(&bar[XB_XGEN(b.x)]) == gen, bar);
      __builtin_amdgcn_fence(__ATOMIC_ACQUIRE, "agent");
      asm volatile("s_waitcnt vmcnt(0)" ::: "memory");
    }
  }
  __syncthreads();
}

struct Out0Order {
  pg8::StaticOrder sl; int extra, c;
  __device__ void init(int G_, int c_) { sl.init(ML, D, G_, c_); extra = (M / 256) * (D / 256) - G_; c = c_; }
  __device__ bool next(int i, pg8::Unit& u) const {
    const bool two = c < extra;
    if (i == 0 && two) { u.pm = ML / 256 + c % (MC / 256); u.pn = c / (MC / 256); return true; }
    if (i == (two ? 1 : 0)) { sl.map(c, u); return true; }
    return false;
  }
  __device__ __forceinline__ void a_ready(const pg8::Unit&) const {}
  __device__ __forceinline__ void done(const pg8::Unit&) const {}
};
struct GEpiOut0Fused {
  static constexpr bool PERM = true, AFTER_DRAIN = true;
  const float *x, *ctx, *mod, *nw; float* XC1; bf16 *X1b, *H; float* slots; XcdBarrier xb;
  __device__ __forceinline__ void operator()(const f32x4 (&acc)[2][2][4][2], const pg8::Unit& u, int wr, int wc, int fr, int fq) const {
    const int rbase = u.pm * 256 - ML;
    const float* gate = mod + ((size_t)0 * NMOD + BATCH) * D3 + 2 * D;
    const int col0 = u.pn * 256 + wc * 32 + 8 * fq;
#pragma unroll
    for (int bj = 0; bj < 2; ++bj) {
      const f32x4 g0 = *(const f32x4*)(gate + col0 + bj * 128), g1 = *(const f32x4*)(gate + col0 + bj * 128 + 4);
#pragma unroll
      for (int ai = 0; ai < 2; ++ai)
#pragma unroll
        for (int m = 0; m < 4; ++m) {
          const size_t off = (size_t)(rbase + wr * 64 + fr + ai * 128 + m * 16) * D + col0 + bj * 128;
          *(f32x4*)(XC1 + off) = *(const f32x4*)(ctx + off) + g0 * acc[ai][bj][m][0];
          *(f32x4*)(XC1 + off + 4) = *(const f32x4*)(ctx + off + 4) + g1 * acc[ai][bj][m][1];
        }
    }
  }
  __device__ __forceinline__ void fused(f32x4 (&acc)[2][2][4][2], const pg8::Unit& u, int wr, int wc, int fr, int fq, LAS unsigned char* lds, int wid, int lane) const {
    const int rowt = u.pm * 256, r_mod = rowt / SEQ;
    const float* gate = mod + ((size_t)0 * NMOD + r_mod) * D3 + 2 * D;
    const int col0 = u.pn * 256 + wc * 32 + 8 * fq;
    LAS float* P = (LAS float*)lds; LAS float* S = (LAS float*)(lds + 8192);
    {
      f32x4 g[2][2];
#pragma unroll
      for (int bj = 0; bj < 2; ++bj)
#pragma unroll
        for (int n = 0; n < 2; ++n) g[bj][n] = *(const f32x4*)(gate + col0 + bj * 128 + n * 4);
#pragma unroll
      for (int ai = 0; ai < 2; ++ai)
#pragma unroll
        for (int m = 0; m < 4; ++m) {
          const int r = ai * 128 + wr * 64 + m * 16 + fr;
          const size_t off = (size_t)(rowt + r) * D + col0;
          float ss = 0.f;
#pragma unroll
          for (int bj = 0; bj < 2; ++bj) {
            const f32x4 o0 = *(const f32x4*)(x + off + bj * 128) + g[bj][0] * acc[ai][bj][m][0], o1 = *(const f32x4*)(x + off + bj * 128 + 4) + g[bj][1] * acc[ai][bj][m][1];
            acc[ai][bj][m][0] = o0; acc[ai][bj][m][1] = o1;
            *(u32x4*)(X1b + off + bj * 128) = pack8<false>(o0, o1);
            ss += (o0[0] * o0[0] + o0[1] * o0[1]) + (o0[2] * o0[2] + o0[3] * o0[3]) + (o1[0] * o1[0] + o1[1] * o1[1]) + (o1[2] * o1[2] + o1[3] * o1[3]);
          }
          ss += __shfl_xor(ss, 16); ss += __shfl_xor(ss, 32);
          if (fq == 0) P[r * 4 + wc] = ss;
          if (m & 1) asm volatile("" ::: "memory");
        }
    }
    asm volatile("s_waitcnt lgkmcnt(0)" ::: "memory"); __builtin_amdgcn_s_barrier(); asm volatile("" ::: "memory");
    const int row = wid * 32 + (lane & 31);
    if (lane < 32) slots[(size_t)(rowt + row) * 8 + u.pn] = (P[row * 4] + P[row * 4 + 1]) + (P[row * 4 + 2] + P[row * 4 + 3]);
    xcd_barrier(xb, wid == 0 && lane == 0);
    if (lane < 32) {
      const f32x4 a = *(const f32x4*)(slots + (size_t)(rowt + row) * 8), b = *(const f32x4*)(slots + (size_t)(rowt + row) * 8 + 4);
      const float t = ((a[0] + a[1]) + (a[2] + a[3])) + ((b[0] + b[1]) + (b[2] + b[3]));
      S[row] = 1.0f / sqrtf(t / D + NORM_EPS);
    }
    asm volatile("s_waitcnt lgkmcnt(0)" ::: "memory"); __builtin_amdgcn_s_barrier(); asm volatile("" ::: "memory");
    const float* md = mod + ((size_t)1 * NMOD + r_mod) * D3; const float* nwp = nw + D;
#pragma unroll
    for (int bj = 0; bj < 2; ++bj) {
      f32x4 mul[2], add[2];
#pragma unroll
      for (int n = 0; n < 2; ++n) {
        const int c = col0 + bj * 128 + n * 4;
        mul[n] = *(const f32x4*)(nwp + c) * ((f32x4){1.f, 1.f, 1.f, 1.f} + *(const f32x4*)(md + D + c)); add[n] = *(const f32x4*)(md + c);
      }
#pragma unroll
      for (int ai = 0; ai < 2; ++ai)
#pragma unroll
        for (int m = 0; m < 4; ++m) {
          const int r = ai * 128 + wr * 64 + m * 16 + fr;
          const float rs = S[r];
          *(u32x4*)(H + (size_t)(rowt + r) * D + col0 + bj * 128) = pack8<false>(acc[ai][bj][m][0] * rs * mul[0] + add[0], acc[ai][bj][m][1] * rs * mul[1] + add[1]);
        }
    }
  }
};
struct GEpiOutFinal {
  static constexpr bool PERM = true, AFTER_DRAIN = true;
  const float *mod, *fw; const bf16* X1b; float *out, *slots; XcdBarrier xb;
  __device__ __forceinline__ void operator()(const f32x4 (&)[2][2][4][2], const pg8::Unit&, int, int, int, int) const {}
  __device__ __forceinline__ void fused(f32x4 (&acc)[2][2][4][2], const pg8::Unit& u, int wr, int wc, int fr, int fq, LAS unsigned char* lds, int wid, int lane) const {
    const int rowt = u.pm * 256;
    const float* gate = mod + ((size_t)1 * NMOD + rowt / SEQ) * D3 + 2 * D;
    const int col0 = u.pn * 256 + wc * 32 + 8 * fq;
    LAS float* P = (LAS float*)lds;
    LAS float* S = (LAS float*)(lds + 8192);
    {
      f32x4 g[2][2];
#pragma unroll
      for (int bj = 0; bj < 2; ++bj)
#pragma unroll
        for (int n = 0; n < 2; ++n) g[bj][n] = *(const f32x4*)(gate + col0 + bj * 128 + n * 4);
#pragma unroll
      for (int ai = 0; ai < 2; ++ai)
#pragma unroll
        for (int m = 0; m < 4; ++m) {
          const int r = ai * 128 + wr * 64 + m * 16 + fr;
          const size_t off = (size_t)(rowt + r) * D + col0;
          float ss = 0.f;
#pragma unroll
          for (int bj = 0; bj < 2; ++bj) {
            const u32x4 w = *(const u32x4*)(X1b + off + bj * 128);
            const f32x4 s0 = {__uint_as_float(w.x << 16), __uint_as_float(w.x & 0xffff0000u), __uint_as_float(w.y << 16), __uint_as_float(w.y & 0xffff0000u)};
            const f32x4 s1 = {__uint_as_float(w.z << 16), __uint_as_float(w.z & 0xffff0000u), __uint_as_float(w.w << 16), __uint_as_float(w.w & 0xffff0000u)};
            const f32x4 o0 = s0 + g[bj][0] * acc[ai][bj][m][0], o1 = s1 + g[bj][1] * acc[ai][bj][m][1];
            acc[ai][bj][m][0] = o0; acc[ai][bj][m][1] = o1;
            ss += (o0[0] * o0[0] + o0[1] * o0[1]) + (o0[2] * o0[2] + o0[3] * o0[3]) + (o1[0] * o1[0] + o1[1] * o1[1]) + (o1[2] * o1[2] + o1[3] * o1[3]);
          }
          ss += __shfl_xor(ss, 16); ss += __shfl_xor(ss, 32);
          if (fq == 0) P[r * 4 + wc] = ss;
          if (m & 1) asm volatile("" ::: "memory");
        }
    }
    asm volatile("s_waitcnt lgkmcnt(0)" ::: "memory"); __builtin_amdgcn_s_barrier(); asm volatile("" ::: "memory");
    const int row = wid * 32 + (lane & 31);
    if (lane < 32) slots[(size_t)(rowt + row) * 8 + u.pn] = (P[row * 4] + P[row * 4 + 1]) + (P[row * 4 + 2] + P[row * 4 + 3]);
    xcd_barrier(xb, wid == 0 && lane == 0);
    if (lane < 32) {
      const f32x4 a = *(const f32x4*)(slots + (size_t)(rowt + row) * 8), b = *(const f32x4*)(slots + (size_t)(rowt + row) * 8 + 4);
      const float t = ((a[0] + a[1]) + (a[2] + a[3])) + ((b[0] + b[1]) + (b[2] + b[3]));
      S[row] = 1.0f / sqrtf(t / D + NORM_EPS);
    }
    asm volatile("s_waitcnt lgkmcnt(0)" ::: "memory"); __builtin_amdgcn_s_barrier(); asm volatile("" ::: "memory");
    f32x4 w[2][2];
#pragma unroll
    for (int bj = 0; bj < 2; ++bj)
#pragma unroll
      for (int n = 0; n < 2; ++n) w[bj][n] = *(const f32x4*)(fw + col0 + bj * 128 + n * 4);
#pragma unroll
    for (int ai = 0; ai < 2; ++ai)
#pragma unroll
      for (int m = 0; m < 4; ++m) {
        const int r = ai * 128 + wr * 64 + m * 16 + fr;
        const float rs = S[r];
        float* op = out + (size_t)(rowt + r) * D + col0;
#pragma unroll
        for (int bj = 0; bj < 2; ++bj) {
          *(f32x4*)(op + bj * 128) = acc[ai][bj][m][0] * rs * w[bj][0];
          *(f32x4*)(op + bj * 128 + 4) = acc[ai][bj][m][1] * rs * w[bj][1];
        }
      }
  }
};

#define FOR_ITEMS(g, N) for (long g = (long)bid * NT + tid; g < (long)(N); g += (long)nb * NT)

constexpr int OUT1_UNITS = (ML / 256) * (D / 256);
constexpr int NPHASES = 17;
template <int PH>
__device__ __forceinline__ void run_phase(const Params& p, int bid, int nb, LAS unsigned char* lds, const int wave_s, const XcdBarrier xb) {
  const int tid = fresh_tid(wave_s);
  const int wave = wave_s, lane = tid & 63;
  const int gw = bid * 8 + wave, ngw = nb * 8;
  LAS float* scr = (LAS float*)(lds + wave * 8704);
  if constexpr (PH == 0) {
    adaln_phase(p, bid, nb, lds, tid);
    __syncthreads();
    FOR_ITEMS(g, (long)SEQ * 32) { float cs, sn; rope_angle((int)(g / 32), (int)(g % 32), cs, sn); p.ROPE[g * 2] = cs; p.ROPE[g * 2 + 1] = sn; }
    transpose_matrix<0>(p.e_w_in, D, EVEN_IN, EVEN_IN, p.Bt0, gw, ngw, scr, lane);
  }
  if constexpr (PH == 1) normmod_phase(p, 0, gw, ngw, lane);
  if constexpr (PH == 2) {
    pg8::StaticOrder S; S.init(M, EVEN_IN, nb, bid);
    pg8::gemm_phase(lds, pg8::Gemm{p.H, p.Bt0, M, EVEN_IN, D}, S, GEpiIn0{p.QKV0, p.U0, p.G0}, tid);
    constexpr int NU2 = (M / 256) * (EVEN_IN / 256);
    const int busy = NU2 % nb;
    if (bid >= busy) {
      const int gw2 = (bid - busy) * 8 + wave, ngw2 = (nb - busy) * 8;
      transpose_matrix<0>(p.e_w_out, 2048, D, D, p.BtOut0, gw2, ngw2, scr, lane);
      rwkv_prep_phase(p, bid - busy, nb - busy, tid);
    }
  }
  if constexpr (PH == 3) rwkv_lr_phase(p, bid, nb, tid);
  if constexpr (PH == 4) {
    { pg8::StaticOrder S; S.init(M, 4096, nb, bid);
      pg8::gemm_phase(lds, pg8::Gemm{p.LRb, p.Btm, M, 4096, 256}, S, GEpiTerms{GEpiTermsP{p.rw_w0, p.rw_a0, p.DL, p.BB}}, tid); }
#ifdef PROBE_TG
    { pg8::StaticOrder S; S.init(M, 4096, nb, bid);
      pg8::gemm_phase(lds, pg8::Gemm{p.LRb, p.Btm, M, 4096, 256}, S, GEpiTerms{GEpiTermsP{p.rw_w0, p.rw_a0, p.DL, p.BB}}, tid); }
#endif
#ifdef PROBE_NA
    __syncthreads(); na_phase(p, bid, nb, nullptr, 0, lds, wave_s);
#endif
  }
  if constexpr (PH == 5) rwkv_fin_phase(p, bid, nb, tid);
#ifdef RWKV_DIRECT
  if constexpr (PH == 6) rwkv_scan_phase(p, bid, nb, lds, wave_s);
#else
  if constexpr (PH == 6) {
    constexpr int NSC = 2 * BATCH * 16;
    if (nb > NSC) {
      unsigned* ctr = (unsigned*)((char*)p.XC1 - 16384) + NA_CTR_WORD;
      if (bid < NSC) { rwkv_chunk_phase(p, bid, NSC, lds, wave_s); na_phase(p, -1, 0, ctr, nb - NSC, lds, wave_s); }
      else na_phase(p, bid - NSC, 0, ctr, nb - NSC, lds, wave_s);
    } else { rwkv_chunk_phase(p, bid, nb, lds, wave_s); na_phase(p, bid, nb, nullptr, 0, lds, wave_s); }
  }
#endif
  if constexpr (PH == 7) rwkv_out_phase(p, bid, nb, tid);
  if constexpr (PH == 8) {
    constexpr int NU8 = (M / 256) * (D / 256);
    const int busy = (NU8 > nb && NU8 < 2 * nb) ? NU8 - nb : 0;
    const bool fuse = FUSED && nb == OUT1_UNITS;
    auto l1_weights = [&]() {
      const int gw2 = (bid - busy) * 8 + wave, ngw2 = (nb - busy) * 8;
      transpose_matrix<1>(p.o_w_in, D, ODD_IN, N1PAD, p.Bt1, gw2, ngw2, scr, lane);
      transpose_matrix<0>(p.o_w_out, 2048, D, D, p.BtOut1, gw2, ngw2, scr, lane);
      transpose_matrix<0>(p.mla_w_uq, 512, 1536, 1536, p.Buq, gw2, ngw2, scr, lane);
      transpose_matrix<0>(p.mla_w_ukv, 512, 2048, 2048, p.Bukv, gw2, ngw2, scr, lane);
    };
    if (fuse) {
      if (bid >= busy) { l1_weights(); __syncthreads(); }
      Out0Order S; S.init(nb, bid);
      pg8::gemm_phase(lds, pg8::Gemm{p.YALL, p.BtOut0, M, D, 2048}, S, GEpiOut0Fused{p.x, p.ctx, p.mod, p.norm_w, p.XC1, p.X1b, p.H, (float*)p.QKV0, xb}, tid);
      normmod_phase(p, 1, gw, ngw, lane, ML);
    } else {
      pg8::StaticOrder S; S.init(M, D, nb, bid);
      pg8::gemm_phase(lds, pg8::Gemm{p.YALL, p.BtOut0, M, D, 2048}, S, GEpiOut<0>{p.x, p.ctx, p.mod, p.XC1, p.X1b, p.X2b}, tid);
      if (bid >= busy) l1_weights();
    }
  }
  if constexpr (PH == 9) { if (!(FUSED && nb == OUT1_UNITS)) normmod_phase(p, 1, gw, ngw, lane); }
  if constexpr (PH == 10) {
    In1OrderAll S; S.init(nb, bid);
    pg8::gemm_phase(lds, pg8::Gemm{p.H, p.Bt1, M, N1PAD, D, p.Bt1 + (size_t)1024 * D, p.H}, S,
                    GEpiIn1All{GEpiIn1{p.CQKV, p.HGQ, p.HGF, p.HGI, p.G1, p.hg_lb}, GEpiHgT{p.HGQ, p.HGF, p.HGI, p.hg_lb}}, tid);
  }
  if constexpr (PH == 11) {
    mla_prep_phase(p, gw, ngw, lane);
  }
  if constexpr (PH == 12) {
    constexpr int NHG = 2 * BATCH * 8 * 2;
    if (nb > NHG) {
      if (bid < NHG) hg_scan_phase(p, bid, NHG, lds, wave_s);
      else { UpOrder S; S.init(nb - NHG, bid - NHG);
        pg8::gemm_phase(lds, pg8::Gemm{p.CQN, p.Buq, ML + M, 1536 + 2048, 512}, S, GEpiUp{GEpiQ{p.Q, p.ROPE}, GEpiKV{p.KV}}, tid); }
    } else {
      hg_scan_phase(p, bid, nb, lds, wave_s);
      UpOrder S; S.init(nb, bid);
      pg8::gemm_phase(lds, pg8::Gemm{p.CQN, p.Buq, ML + M, 1536 + 2048, 512}, S, GEpiUp{GEpiQ{p.Q, p.ROPE}, GEpiKV{p.KV}}, tid);
    }
  }
  if constexpr (PH == 14) {
    hg_out_phase(p, bid, nb, tid);
    mla_phase(p, bid, nb, lds, wave_s);
  }
  if constexpr (PH == 15) {
    pg8::StaticOrder S; S.init(ML, D, nb, bid);
    if (FUSED && nb == OUT1_UNITS)
      pg8::gemm_phase(lds, pg8::Gemm{p.YALL, p.BtOut1, ML, D, 2048}, S, GEpiOutFinal{p.mod, p.final_norm_w, p.X1b, p.out, (float*)p.HGI, xb}, tid);
    else
      pg8::gemm_phase(lds, pg8::Gemm{p.YALL, p.BtOut1, ML, D, 2048}, S, GEpiOut<1>{p.x, p.ctx, p.mod, p.XC1, p.X1b, p.X2b}, tid);
  }
  if constexpr (PH == 16) { if (!(FUSED && nb == OUT1_UNITS)) final_phase(p, gw, ngw, lane); }
}

#if FUSED
template <int PH>
__device__ __forceinline__ void run_from(const Params& p, cg::grid_group& grid, LAS unsigned char* lds, const int wave_s, const XcdBarrier& xb) {
  if constexpr (PH != 13) {
    if constexpr ((PROBE_DUP >> PH) & 1) { run_phase<PH>(p, blockIdx.x, gridDim.x, lds, wave_s, xb); xcd_barrier(xb, fresh_tid(wave_s) == 0); }
    if constexpr (PH == 9) { if (gridDim.x == OUT1_UNITS) { run_from<PH + 1>(p, grid, lds, wave_s, xb); return; } }
    run_phase<PH>(p, blockIdx.x, gridDim.x, lds, wave_s, xb);
    if constexpr (PH + 1 < NPHASES) { if (!(PH == 15 && gridDim.x == OUT1_UNITS)) xcd_barrier(xb, fresh_tid(wave_s) == 0); }
  }
  if constexpr (PH + 1 < NPHASES) run_from<PH + 1>(p, grid, lds, wave_s, xb);
}
__global__ void __launch_bounds__(NT) mega_kernel(const Params p) {
  extern __shared__ __attribute__((aligned(16))) unsigned char lds_raw[];
  LAS unsigned char* lds = (LAS unsigned char*)lds_raw;
  cg::grid_group grid = cg::this_grid();
  const int wave_s = __builtin_amdgcn_readfirstlane(threadIdx.x >> 6);
  volatile LAS unsigned* xst = (volatile LAS unsigned*)(lds + LDS_BYTES - 16);
  { const int t = fresh_tid(wave_s); if (t < 4) xst[t] = 0u; }
  __syncthreads();
  const XcdBarrier xb = xcd_barrier_post((unsigned*)((char*)p.XC1 - 16384), xst, fresh_tid(wave_s) == 0);
  grid.sync();
  run_from<0>(p, grid, lds, wave_s, xb);
}
#else
template <int PH>
__global__ void __launch_bounds__(NT) phase_kernel(const Params p) {
  extern __shared__ __attribute__((aligned(16))) unsigned char lds_raw[];
  LAS unsigned char* lds = (LAS unsigned char*)lds_raw;
  run_phase<PH>(p, blockIdx.x, gridDim.x, lds, __builtin_amdgcn_readfirstlane(threadIdx.x >> 6), XcdBarrier{});
}
template <int PH>
static void launch_from(const Params& p, hipStream_t stream) {
  (void)hipFuncSetAttribute((const void*)phase_kernel<PH>, hipFuncAttributeMaxDynamicSharedMemorySize, LDS_BYTES);
  phase_kernel<PH><<<dim3(256), dim3(NT), LDS_BYTES, stream>>>(p);
  if constexpr (PH + 1 < NPHASES) launch_from<PH + 1>(p, stream);
}
#endif

extern "C" void kernel_launch(void* const* d_in, const int* in_sizes, int n_in, void* d_out, int out_size, void* d_ws, size_t ws_size,
                              hipStream_t stream) {
  Params p;
  memset(&p, 0, sizeof(p));
  const float** f = (const float**)&p;
  for (int i = 0; i < 29; i++) f[i] = (const float*)d_in[i];
  p.out = (float*)d_out;
  const size_t need = setup_ws(p, (unsigned char*)d_ws, (unsigned char*)d_out);
  if (need > ws_size) { fprintf(stderr, "kernel_launch: workspace too small: need %zu have %zu\n", need, ws_size); return; }
#if FUSED
  static int grid_blocks = 0;
  if (!grid_blocks) {
    int dev = 0, cus = 0, per_cu = 0;
    (void)hipGetDevice(&dev);
    (void)hipDeviceGetAttribute(&cus, hipDeviceAttributeMultiprocessorCount, dev);
    (void)hipFuncSetAttribute((const void*)mega_kernel, hipFuncAttributeMaxDynamicSharedMemorySize, LDS_BYTES);
    (void)hipOccupancyMaxActiveBlocksPerMultiprocessor(&per_cu, mega_kernel, NT, LDS_BYTES);
    if (per_cu > 1) per_cu = 1;
    grid_blocks = cus * per_cu;
  }
  (void)hipMemsetAsync((char*)p.XC1 - 16384, 0, 16384, stream);
  void* args[] = {(void*)&p};
  hipError_t e = hipLaunchCooperativeKernel((void*)mega_kernel, dim3(grid_blocks), dim3(NT), args, LDS_BYTES, stream);
  if (e != hipSuccess) fprintf(stderr, "cooperative launch failed: %s (grid %d)\n", hipGetErrorString(e), grid_blocks);
#else
  launch_from<0>(p, stream);
#endif
}
#endif
```
